# Optimizing an MI355X kernel written in HIP

```python
import math
import jax
import jax.numpy as jnp
from jax import lax
import numpy as np


D_MODEL = 1024
BATCH = 8
SEQ = 4096
DEPTH = 4

DIFF_HEADS = 4
DIFF_QK_DIM = 64
DIFF_V_DIM = 2 * DIFF_QK_DIM
DIFF_WIDTH = DIFF_HEADS * DIFF_V_DIM
RET_HEADS = 8
RET_QK_DIM = 64
RET_V_DIM = 64
RET_WIDTH = RET_HEADS * RET_V_DIM
MIX_WIDTH = DIFF_WIDTH + RET_WIDTH
D_FF = 4 * D_MODEL
Q_BLOCK = 128
RET_CHUNK = 128
NORM_EPS = 1e-6
IN_SIZES = (DIFF_HEADS * 2 * DIFF_QK_DIM, DIFF_HEADS * 2 * DIFF_QK_DIM, DIFF_WIDTH,
            RET_HEADS * RET_QK_DIM, RET_HEADS * RET_QK_DIM, RET_WIDTH, RET_WIDTH)
IN_WIDTH = sum(IN_SIZES)

kernel_name = 'hybrid_diffattn_retention_encoder'


def rms_norm(x, g):
    xf = x.astype(jnp.float32)
    y = xf * lax.rsqrt(jnp.mean(xf * xf, axis=-1, keepdims=True) + NORM_EPS)
    return (y * g.astype(jnp.float32)).astype(x.dtype)


def group_norm(x, g):
    xf = x.astype(jnp.float32)
    mu = jnp.mean(xf, axis=-1, keepdims=True)
    xc = xf - mu
    var = jnp.mean(xc * xc, axis=-1, keepdims=True)
    return (xc * lax.rsqrt(var + NORM_EPS) * g.astype(jnp.float32)).astype(x.dtype)


def lambda_init(layer):
    return 0.8 - 0.6 * math.exp(-0.3 * layer)


def diff_attention(q, k, v, lam, slopes):
    B, H, _, S, dk = q.shape
    dv = v.shape[-1]
    nb = S // Q_BLOCK
    qb = q.reshape(B, H, 2, nb, Q_BLOCK, dk).transpose(3, 0, 1, 2, 4, 5)
    starts = jnp.arange(nb, dtype=jnp.int32) * Q_BLOCK
    kpos = jnp.arange(S, dtype=jnp.int32)
    scale = dk ** -0.5

    def block(args):
        q_blk, start = args
        qpos = start + jnp.arange(Q_BLOCK, dtype=jnp.int32)
        dist = jnp.abs(qpos[:, None] - kpos[None, :]).astype(jnp.float32)
        bias = -slopes[:, None, None] * dist
        s = jnp.einsum('bhcqd,bhckd->bhcqk', q_blk, k).astype(jnp.float32) * scale
        p = jax.nn.softmax(s + bias[None, :, None], axis=-1)
        a = p[:, :, 0] - lam[None, :, None, None] * p[:, :, 1]
        return jnp.einsum('bhqk,bhkd->bhqd', a.astype(v.dtype), v)

    out = lax.map(block, (qb, starts))
    return out.transpose(1, 0, 3, 2, 4).reshape(B, S, H, dv)


def retention_scan(q, k, v, log_g, strict):
    B, H, S, dk = q.shape
    dv = v.shape[-1]
    C = RET_CHUNK
    n = S // C
    qc = q.reshape(B, H, n, C, dk)
    kc = k.reshape(B, H, n, C, dk)
    vc = v.reshape(B, H, n, C, dv)
    idx = jnp.arange(C, dtype=jnp.float32)
    rel = idx[:, None] - idx[None, :]
    mask = (rel > 0) if strict else (rel >= 0)
    decay = jnp.where(mask, jnp.exp(log_g[:, None, None] * jnp.maximum(rel, 0.0)), 0.0).astype(v.dtype)
    scores = jnp.einsum('bhncd,bhnjd->bhncj', qc, kc) * decay[None, :, None]
    intra = jnp.einsum('bhncj,bhnje->bhnce', scores, vc)
    k_w = jnp.exp(log_g[:, None] * (C - 1.0 - idx)[None, :]).astype(v.dtype)
    chunk_kv = jnp.einsum('bhnjd,hj,bhnje->nbhde', kc, k_w, vc)
    g_chunk = jnp.exp(log_g * C).astype(v.dtype)[None, :, None, None]

    def step(state, kv):
        return g_chunk * state + kv, state

    _, prev = lax.scan(step, jnp.zeros((B, H, dk, dv), v.dtype), chunk_kv)
    q_w = jnp.exp(log_g[:, None] * (idx + 1.0)[None, :]).astype(v.dtype)
    cross = jnp.einsum('bhncd,nbhde->bhnce', qc, prev) * q_w[None, :, None, :, None]
    return (intra + cross).reshape(B, H, S, dv)


def setup_inputs(seed: int = 0) -> dict:
    key = jax.random.key(seed)
    ks = jax.random.split(key, 17)

    def nrm(k, shape, scale):
        return jax.random.normal(k, shape, jnp.float32) * scale

    base_decay = jnp.log(2.0 ** (5.0 + jnp.arange(RET_HEADS, dtype=jnp.float32)) - 1.0)
    return {
        'x': nrm(ks[0], (BATCH, SEQ, D_MODEL), 1.0),
        'norm1_g': 1.0 + nrm(ks[1], (DEPTH, D_MODEL), 0.02),
        'w_in': nrm(ks[2], (DEPTH, D_MODEL, IN_WIDTH), D_MODEL ** -0.5),
        'q_norm_g': 1.0 + nrm(ks[3], (DEPTH, DIFF_QK_DIM), 0.02),
        'k_norm_g': 1.0 + nrm(ks[4], (DEPTH, DIFF_QK_DIM), 0.02),
        'lambda_q1': nrm(ks[5], (DEPTH, DIFF_HEADS, DIFF_QK_DIM), 0.1),
        'lambda_k1': nrm(ks[6], (DEPTH, DIFF_HEADS, DIFF_QK_DIM), 0.1),
        'lambda_q2': nrm(ks[7], (DEPTH, DIFF_HEADS, DIFF_QK_DIM), 0.1),
        'lambda_k2': nrm(ks[8], (DEPTH, DIFF_HEADS, DIFF_QK_DIM), 0.1),
        'diff_out_g': 1.0 + nrm(ks[9], (DEPTH, DIFF_WIDTH), 0.02),
        'ret_decay_fwd': base_decay + nrm(ks[10], (DEPTH, RET_HEADS), 0.05),
        'ret_decay_bwd': base_decay + nrm(ks[11], (DEPTH, RET_HEADS), 0.05),
        'ret_gn_g': 1.0 + nrm(ks[12], (DEPTH, RET_WIDTH), 0.02),
        'w_out': nrm(ks[13], (DEPTH, MIX_WIDTH, D_MODEL), MIX_WIDTH ** -0.5),
        'norm2_g': 1.0 + nrm(ks[14], (DEPTH, D_MODEL), 0.02),
        'w_mlp1': nrm(ks[15], (DEPTH, D_MODEL, D_FF), D_MODEL ** -0.5),
        'w_mlp2': nrm(ks[16], (DEPTH, D_FF, D_MODEL), D_FF ** -0.5),
    }


def reference(x, norm1_g, w_in, q_norm_g, k_norm_g, lambda_q1, lambda_k1, lambda_q2, lambda_k2,
              diff_out_g, ret_decay_fwd, ret_decay_bwd, ret_gn_g, w_out, norm2_g, w_mlp1, w_mlp2):
    B, S, _ = x.shape
    slopes = jnp.power(2.0, -8.0 * jnp.arange(1, DIFF_HEADS + 1, dtype=jnp.float32) / DIFF_HEADS)
    offsets = np.cumsum(IN_SIZES)[:-1].tolist()
    for l in range(DEPTH):
        h = rms_norm(x, norm1_g[l])
        proj = h @ w_in[l]
        dq, dk, dv, rq, rk, rv, rg = jnp.split(proj, offsets, axis=-1)

        dq = rms_norm(dq.reshape(B, S, DIFF_HEADS, 2, DIFF_QK_DIM), q_norm_g[l]).transpose(0, 2, 3, 1, 4)
        dk = rms_norm(dk.reshape(B, S, DIFF_HEADS, 2, DIFF_QK_DIM), k_norm_g[l]).transpose(0, 2, 3, 1, 4)
        dv = dv.reshape(B, S, DIFF_HEADS, DIFF_V_DIM).transpose(0, 2, 1, 3)
        lam_init = lambda_init(l)
        lam = (jnp.exp(jnp.sum(lambda_q1[l].astype(jnp.float32) * lambda_k1[l].astype(jnp.float32), axis=-1))
               - jnp.exp(jnp.sum(lambda_q2[l].astype(jnp.float32) * lambda_k2[l].astype(jnp.float32), axis=-1))
               + lam_init)
        a = diff_attention(dq, dk, dv, lam, slopes)
        a = rms_norm(a, diff_out_g[l].reshape(DIFF_HEADS, DIFF_V_DIM)) * (1.0 - lam_init)
        a = a.reshape(B, S, DIFF_WIDTH)

        rq = rq.reshape(B, S, RET_HEADS, RET_QK_DIM).transpose(0, 2, 1, 3)
        rk = rk.reshape(B, S, RET_HEADS, RET_QK_DIM).transpose(0, 2, 1, 3) * (RET_QK_DIM ** -0.5)
        rv = rv.reshape(B, S, RET_HEADS, RET_V_DIM).transpose(0, 2, 1, 3)
        lg_f = jax.nn.log_sigmoid(ret_decay_fwd[l].astype(jnp.float32))
        lg_b = jax.nn.log_sigmoid(ret_decay_bwd[l].astype(jnp.float32))
        y_f = retention_scan(rq, rk, rv, lg_f, False)
        y_b = jnp.flip(retention_scan(jnp.flip(rq, 2), jnp.flip(rk, 2), jnp.flip(rv, 2), lg_b, True), 2)
        y = (y_f + y_b).transpose(0, 2, 1, 3)
        y = group_norm(y, ret_gn_g[l].reshape(RET_HEADS, RET_V_DIM)).reshape(B, S, RET_WIDTH)
        y = jax.nn.silu(rg) * y

        mix = jnp.concatenate([a, y], axis=-1)
        x = x + mix @ w_out[l]

        h = rms_norm(x, norm2_g[l])
        u = jax.nn.relu(h @ w_mlp1[l])
        x = x + (u * u) @ w_mlp2[l]
    return x
```

```cpp
#include <hip/hip_runtime.h>
#include <hip/hip_cooperative_groups.h>
#include <cstdio>
#include <cstdint>
namespace cg = cooperative_groups;
__device__ __forceinline__ int fresh_tid() { int t = threadIdx.x; asm volatile("" : "+v"(t)); return t; }
namespace pg8 {
#define PG8_LAS __attribute__((address_space(3)))
typedef unsigned short bf16_t;
typedef short bf16x8 __attribute__((ext_vector_type(8)));
typedef float f32x4 __attribute__((ext_vector_type(4)));
typedef unsigned u32x4 __attribute__((ext_vector_type(4)));
constexpr int BM = 256, BK = 64, HALF = 128, HTB = HALF * BK * 2  , STAGE_BYTES = 8 * HTB, NXCD = 8, WGM = 8;

__host__ __device__ __forceinline__ int lds_byte(int r, int c) { const int st = (r >> 4) * 2 + (c >> 5), rr = r & 15, cc = c & 31, ob = rr * 64 + cc * 2; return st * 1024 + (ob ^ (((ob >> 9) & 1) << 5)); }
__host__ __device__ __forceinline__ void stage_rc(int b, int& R, int& C) { const int st = b / 1024, sb = b % 1024, swz = sb ^ (((sb >> 9) & 1) << 5); R = (st >> 1) * 16 + swz / 64; C = (st & 1) * 32 + (swz % 64) / 2; }
__host__ __device__ __forceinline__ int perm32(int rho) { const int n = rho >> 4, i = rho & 15; return 8 * (i >> 2) + 4 * n + (i & 3); }

struct Unit { int pm, pn; };
struct Gemm { const bf16_t* A; const bf16_t* Bt; int M, N, K; };

struct StaticOrder {
    int nM, nN, nwg, G, c, rev;
    __host__ __device__ void init(int M, int N, int G_, int c_, int rev_ = 0) { nM = M / BM; nN = N / BM; nwg = nM * nN; G = G_; c = c_; rev = (rev_ && nwg % G_ == 0) ? 1 : 0; }
    __host__ __device__ bool next(int i, Unit& u) const {
        if (rev && i >= nwg / G) return false;
        const long L = (long)(rev ? nwg / G - 1 - i : i) * G + c; if (L >= nwg) return false;
        int wgid = (int)L; { const int q = nwg / NXCD, r = nwg % NXCD, xcd = wgid % NXCD, off = wgid / NXCD; wgid = (xcd < r ? xcd * (q + 1) : r * (q + 1) + (xcd - r) * q) + off; }
        const int nig = WGM * nN, gid = wgid / nig, fm = gid * WGM, gsz = (nM - fm) < WGM ? (nM - fm) : WGM;
        u.pm = fm + ((wgid % nig) % gsz); u.pn = (wgid % nig) / gsz; return true;
    }
    __device__ __forceinline__ void a_ready(const Unit&) const {}
    __device__ __forceinline__ void done(const Unit&) const {}
};

__device__ __forceinline__ unsigned cvt_pk_bf16(float lo, float hi) { unsigned r; asm volatile("v_cvt_pk_bf16_f32 %0, %1, %2" : "=v"(r) : "v"(lo), "v"(hi)); return r; }
typedef float f32x2 __attribute__((ext_vector_type(2)));
typedef unsigned u32x2 __attribute__((ext_vector_type(2)));
__device__ __forceinline__ float row_ss(const float* part, int row) { const f32x4* p = (const f32x4*)(part + (size_t)row * 16); const f32x4 a = (p[0] + p[1]) + (p[2] + p[3]); return (a[0] + a[1]) + (a[2] + a[3]); }
struct EpiProj {
    static constexpr bool PERM = true, AFTER_DRAIN = false;
    bf16_t* P; size_t sec_stride;
    const float* qg; const float* kg;
    const PG8_LAS float* rrt;
    __device__ __forceinline__ void operator()(const f32x4 (&acc)[2][2][4][2], const Unit& u, int wr, int wc, int fr, int fq) const {
        const int sec = u.pn >> 1;
        bf16_t* base = P + (size_t)sec * sec_stride;
        const int row0 = u.pm * BM + wr * 64 + fr;
        const int colb = (u.pn & 1) * 256 + wc * 64 + 8 * fq;
        float rr[2][4];
#pragma unroll
        for (int ai = 0; ai < 2; ++ai)
#pragma unroll
            for (int m = 0; m < 4; ++m) rr[ai][m] = rrt[(u.pm & 15) * 256 + wr * 64 + fr + ai * HALF + m * 16];
        if (sec <= 1) {
            const float* g = sec == 0 ? qg : kg;
            const float osc = sec == 0 ? 0.125f * 1.4426950408889634f : 1.0f;
            f32x4 gv[2][2];
#pragma unroll
            for (int bj = 0; bj < 2; ++bj)
#pragma unroll
                for (int n = 0; n < 2; ++n) gv[bj][n] = *(const f32x4*)(g + 32 * bj + 8 * fq + 4 * n) * osc;
#pragma unroll
            for (int ai = 0; ai < 2; ++ai)
#pragma unroll
                for (int m = 0; m < 4; ++m) {
                    float ss = 0.f;
#pragma unroll
                    for (int bj = 0; bj < 2; ++bj)
#pragma unroll
                        for (int n = 0; n < 2; ++n) { const f32x4 v = acc[ai][bj][m][n] * rr[ai][m]; ss += (v[0] * v[0] + v[1] * v[1]) + (v[2] * v[2] + v[3] * v[3]); }
                    ss += __shfl_xor(ss, 16); ss += __shfl_xor(ss, 32);
                    const float r = rr[ai][m] / sqrtf(ss * (1.0f / 64.0f) + 1e-6f);
                    bf16_t* rowp = base + (size_t)(row0 + ai * HALF + m * 16) * 512 + colb;
#pragma unroll
                    for (int bj = 0; bj < 2; ++bj) {
                        const f32x4 v0 = acc[ai][bj][m][0] * r * gv[bj][0], v1 = acc[ai][bj][m][1] * r * gv[bj][1];
                        u32x4 w; w.x = cvt_pk_bf16(v0[0], v0[1]); w.y = cvt_pk_bf16(v0[2], v0[3]); w.z = cvt_pk_bf16(v1[0], v1[1]); w.w = cvt_pk_bf16(v1[2], v1[3]);
                        *(u32x4*)(rowp + bj * 32) = w; }
                }
        } else {
            const float sc0 = sec == 4 ? 0.125f : 1.0f;
#pragma unroll
            for (int ai = 0; ai < 2; ++ai)
#pragma unroll
                for (int m = 0; m < 4; ++m) {
                    bf16_t* rowp = base + (size_t)(row0 + ai * HALF + m * 16) * 512 + colb; const float sc = sc0 * rr[ai][m];
#pragma unroll
                    for (int bj = 0; bj < 2; ++bj) {
                        const f32x4 v0 = acc[ai][bj][m][0] * sc, v1 = acc[ai][bj][m][1] * sc;
                        u32x4 w; w.x = cvt_pk_bf16(v0[0], v0[1]); w.y = cvt_pk_bf16(v0[2], v0[3]); w.z = cvt_pk_bf16(v1[0], v1[1]); w.w = cvt_pk_bf16(v1[2], v1[3]);
                        *(u32x4*)(rowp + bj * 32) = w; }
                }
        }
    }
};
__device__ __forceinline__ float bf_lo(unsigned w) { return __builtin_bit_cast(float, w << 16); }
__device__ __forceinline__ float bf_hi(unsigned w) { return __builtin_bit_cast(float, w & 0xffff0000u); }
struct EpiRes {
    static constexpr bool PERM = true, AFTER_DRAIN = false;
    bf16_t* xn; float* outf; int ldc; float* rowss;
    __device__ __forceinline__ void operator()(const f32x4 (&acc)[2][2][4][2], const Unit& u, int wr, int wc, int fr, int fq) const {
        const int col0 = u.pn * BM + wc * 32 + 8 * fq;
#pragma unroll
        for (int ai = 0; ai < 2; ++ai)
#pragma unroll
            for (int m = 0; m < 4; ++m) { const int row = u.pm * BM + ai * HALF + wr * 64 + m * 16 + fr; const size_t off = (size_t)row * ldc + col0; float ss = 0.f;
#pragma unroll
                for (int bj = 0; bj < 2; ++bj) { const u32x4 xb = *(const u32x4*)(xn + off + bj * HALF);
                    const f32x4 o0 = (f32x4){bf_lo(xb.x), bf_hi(xb.x), bf_lo(xb.y), bf_hi(xb.y)} + acc[ai][bj][m][0], o1 = (f32x4){bf_lo(xb.z), bf_hi(xb.z), bf_lo(xb.w), bf_hi(xb.w)} + acc[ai][bj][m][1];
                    if (outf) { *(f32x4*)(outf + off + bj * HALF) = o0; *(f32x4*)(outf + off + bj * HALF + 4) = o1; }
                    else { u32x4 w; w.x = cvt_pk_bf16(o0[0], o0[1]); w.y = cvt_pk_bf16(o0[2], o0[3]); w.z = cvt_pk_bf16(o1[0], o1[1]); w.w = cvt_pk_bf16(o1[2], o1[3]); *(u32x4*)(xn + off + bj * HALF) = w;
                        ss += ((o0[0] * o0[0] + o0[1] * o0[1]) + (o0[2] * o0[2] + o0[3] * o0[3])) + ((o1[0] * o1[0] + o1[1] * o1[1]) + (o1[2] * o1[2] + o1[3] * o1[3])); } }
                if (!outf) { ss += __shfl_xor(ss, 16); ss += __shfl_xor(ss, 32); if (fq == 0) rowss[(size_t)row * 16 + u.pn * 4 + wc] = ss; } }
    }
};
struct EpiRelu2 {
    static constexpr bool PERM = true, AFTER_DRAIN = false;
    bf16_t* O; int ldc; const PG8_LAS float* rrt;
    __device__ __forceinline__ void operator()(const f32x4 (&acc)[2][2][4][2], const Unit& u, int wr, int wc, int fr, int fq) const {
        const int row0 = u.pm * BM + wr * 64 + fr, col0 = u.pn * BM + wc * 32 + 8 * fq;
#pragma unroll
        for (int ai = 0; ai < 2; ++ai)
#pragma unroll
            for (int m = 0; m < 4; ++m) { bf16_t* rowp = O + (size_t)(row0 + ai * HALF + m * 16) * ldc + col0;
                const float rr = rrt[(u.pm & 15) * 256 + wr * 64 + fr + ai * HALF + m * 16];
#pragma unroll
                for (int bj = 0; bj < 2; ++bj) {
                    f32x4 v0 = acc[ai][bj][m][0], v1 = acc[ai][bj][m][1];
#pragma unroll
                    for (int e = 0; e < 4; ++e) { const float a = fmaxf(v0[e], 0.f) * rr, b = fmaxf(v1[e], 0.f) * rr; v0[e] = a * a; v1[e] = b * b; }
                    u32x4 w; w.x = cvt_pk_bf16(v0[0], v0[1]); w.y = cvt_pk_bf16(v0[2], v0[3]); w.z = cvt_pk_bf16(v1[0], v1[1]); w.w = cvt_pk_bf16(v1[2], v1[3]);
                    *(u32x4*)(rowp + bj * HALF) = w; } }
    }
};
template <class Epi, class Sched, bool ALIGN_EPI = false, bool SP2 = false>
__device__ __forceinline__ void gemm_phase(PG8_LAS unsigned char* lds, const Gemm g, const Sched& S, const Epi& E) {
    const int tid = fresh_tid(), wid = __builtin_amdgcn_readfirstlane(tid >> 6), lane = tid & 63, wr = wid >> 2, wc = wid & 3, fr = lane & 15, fq = lane >> 4;
    const int K = g.K, nt = K / BK;
    unsigned voffA[2], voffB[2];
#pragma unroll
    for (int i = 0; i < 2; ++i) { int R, C; stage_rc(tid * 16 + i * 8192, R, C); const int Rb = Epi::PERM ? ((R & ~31) + perm32(R & 31)) : R;
        voffA[i] = (unsigned)(R * K + C) * 2u; voffB[i] = (unsigned)(Rb * K + C) * 2u; }
    const size_t kstep = (size_t)(BK * 2);
    const size_t hstep = (size_t)HALF * K * 2;
    const size_t tstep = 2 * hstep;
    const unsigned ldsw = (unsigned)wid * 1024u;
    const int aoff = lds_byte(wr * 64 + fr, fq * 8), boff = lds_byte(wc * 32 + fr, fq * 8);
#define PG8_SA(b, h) (((b) * 2 + (h)) * HTB)
#define PG8_SB(b, h) ((4 + (b) * 2 + (h)) * HTB)
#define PG8_STAGE(bufoff, gbase, voff) do { _Pragma("unroll") for (int _i = 0; _i < 2; ++_i) \
        __builtin_amdgcn_global_load_lds((const unsigned*)((const char*)(gbase) + (voff)[_i]), (PG8_LAS unsigned*)(lds + (bufoff) + ldsw + _i * 8192), 16, 0, 0); } while (0)
#define PG8_LDA(dst, b, h) do { _Pragma("unroll") for (int m = 0; m < 4; ++m) _Pragma("unroll") for (int k = 0; k < 2; ++k) dst[m][k] = *(const PG8_LAS bf16x8*)(lds + PG8_SA(b, h) + aoff + m * 2048 + k * 1024); } while (0)
#define PG8_LDB(dst, b, h) do { _Pragma("unroll") for (int n = 0; n < 2; ++n) _Pragma("unroll") for (int k = 0; k < 2; ++k) dst[n][k] = *(const PG8_LAS bf16x8*)(lds + PG8_SB(b, h) + boff + n * 2048 + k * 1024); } while (0)
#define PG8_MMA(ai, bj, At, Bt) do { __builtin_amdgcn_s_setprio(1); _Pragma("unroll") for (int m = 0; m < 4; ++m) _Pragma("unroll") for (int n = 0; n < 2; ++n) _Pragma("unroll") for (int k = 0; k < 2; ++k) \
        acc[ai][bj][m][n] = __builtin_amdgcn_mfma_f32_16x16x32_bf16(Bt[n][k], At[m][k], acc[ai][bj][m][n], 0, 0, 0); __builtin_amdgcn_s_setprio(0); } while (0)
#define PG8_WAIT_V(n) asm volatile("s_waitcnt vmcnt(" #n ")" ::: "memory")
#define PG8_WAIT_L(n) asm volatile("s_waitcnt lgkmcnt(" #n ")" ::: "memory")
#define PG8_BAR __builtin_amdgcn_s_barrier()
#define PG8_SCHED __builtin_amdgcn_sched_barrier(0)
    Unit cur, nxt; int ui = 0;
    if (!S.next(0, cur)) return;
    f32x4 acc[2][2][4][2];
#pragma unroll
    for (int a = 0; a < 2; ++a)
#pragma unroll
        for (int b = 0; b < 2; ++b)
#pragma unroll
            for (int m = 0; m < 4; ++m)
#pragma unroll
                for (int n = 0; n < 2; ++n) acc[a][b][m][n] = (f32x4){0.f, 0.f, 0.f, 0.f};
    bf16x8 At[4][2], B0[2][2], B1[2][2];
    const char* cA = (const char*)g.A + (size_t)cur.pm * tstep; const char* cB = (const char*)g.Bt + (size_t)cur.pn * tstep;
    S.a_ready(cur);
    if constexpr (SP2) {
        PG8_STAGE(PG8_SB(0, 0), cB, voffB); PG8_STAGE(PG8_SB(0, 1), cB + hstep, voffB); PG8_STAGE(PG8_SA(0, 0), cA, voffA); PG8_STAGE(PG8_SA(0, 1), cA + hstep, voffA);
        if (wr == 1) PG8_BAR;
        PG8_WAIT_V(2); PG8_BAR;
        PG8_STAGE(PG8_SB(1, 0), cB + kstep, voffB); PG8_STAGE(PG8_SA(1, 0), cA + kstep, voffA); PG8_STAGE(PG8_SB(1, 1), cB + hstep + kstep, voffB);
        PG8_WAIT_V(6); PG8_BAR;
    } else {
        PG8_STAGE(PG8_SB(0, 0), cB, voffB); PG8_STAGE(PG8_SA(0, 0), cA, voffA); PG8_STAGE(PG8_SB(0, 1), cB + hstep, voffB); PG8_STAGE(PG8_SA(0, 1), cA + hstep, voffA);
        if (wr == 1) PG8_BAR;
        PG8_WAIT_V(4); PG8_BAR;
        PG8_STAGE(PG8_SB(1, 0), cB + kstep, voffB); PG8_STAGE(PG8_SA(1, 0), cA + kstep, voffA); PG8_STAGE(PG8_SB(1, 1), cB + hstep + kstep, voffB);
        PG8_WAIT_V(6); PG8_BAR;
    }
    for (;;) {
        const bool has_next = S.next(ui + 1, nxt);
        const char* nA = has_next ? (const char*)g.A + (size_t)nxt.pm * tstep : cA; const char* nB = has_next ? (const char*)g.Bt + (size_t)nxt.pn * tstep : cB;
        for (int t = 0; t < nt; t += 2) {
            const bool last = (t == nt - 2);
            const char* a1 = cA + (size_t)(t + 1) * kstep;
            const char* a2 = last ? nA : cA + (size_t)(t + 2) * kstep; const char* b2 = last ? nB : cB + (size_t)(t + 2) * kstep;
            const char* a3 = a2 + kstep; const char* b3 = b2 + kstep;
            if (last && has_next) S.a_ready(nxt);
            if constexpr (SP2) {
            PG8_LDB(B0, 0, 0); PG8_LDB(B1, 0, 1); PG8_SCHED; PG8_LDA(At, 0, 0); PG8_STAGE(PG8_SA(1, 1), a1 + hstep, voffA);
            PG8_WAIT_V(8); PG8_WAIT_L(0); PG8_BAR; PG8_MMA(0, 0, At, B0); PG8_MMA(0, 1, At, B1); PG8_BAR; PG8_SCHED;
            PG8_LDA(At, 0, 1); PG8_STAGE(PG8_SB(0, 0), b2, voffB); PG8_STAGE(PG8_SB(0, 1), b2 + hstep, voffB); PG8_STAGE(PG8_SA(0, 0), a2, voffA);
            PG8_WAIT_V(8); PG8_WAIT_L(0); PG8_BAR; PG8_MMA(1, 0, At, B0); PG8_MMA(1, 1, At, B1); PG8_BAR; PG8_SCHED;
            PG8_LDB(B0, 1, 0); PG8_LDB(B1, 1, 1); PG8_SCHED; PG8_LDA(At, 1, 0); PG8_STAGE(PG8_SA(0, 1), a2 + hstep, voffA);
            PG8_WAIT_V(8); PG8_WAIT_L(0); PG8_BAR; PG8_MMA(0, 0, At, B0); PG8_MMA(0, 1, At, B1); PG8_BAR; PG8_SCHED;
            PG8_LDA(At, 1, 1); PG8_STAGE(PG8_SB(1, 0), b3, voffB); PG8_STAGE(PG8_SB(1, 1), b3 + hstep, voffB); PG8_STAGE(PG8_SA(1, 0), a3, voffA);
            PG8_WAIT_V(8); PG8_WAIT_L(0); PG8_BAR; PG8_MMA(1, 0, At, B0); PG8_MMA(1, 1, At, B1); PG8_BAR; PG8_SCHED;
            } else {
            PG8_LDB(B0, 0, 0); PG8_SCHED; PG8_LDA(At, 0, 0); PG8_STAGE(PG8_SA(1, 1), a1 + hstep, voffA);
            PG8_WAIT_L(8); PG8_BAR; PG8_WAIT_L(0); PG8_MMA(0, 0, At, B0); PG8_BAR; PG8_SCHED;
            PG8_LDB(B1, 0, 1); PG8_STAGE(PG8_SB(0, 0), b2, voffB);
            PG8_BAR; PG8_WAIT_L(0); PG8_MMA(0, 1, At, B1); PG8_BAR;
            PG8_LDA(At, 0, 1); PG8_STAGE(PG8_SA(0, 0), a2, voffA);
            PG8_BAR; PG8_WAIT_L(0); PG8_MMA(1, 0, At, B0); PG8_BAR; PG8_SCHED;
            PG8_STAGE(PG8_SB(0, 1), b2 + hstep, voffB);
            PG8_WAIT_V(6); PG8_BAR; PG8_MMA(1, 1, At, B1); PG8_BAR;
            PG8_LDB(B0, 1, 0); PG8_SCHED; PG8_LDA(At, 1, 0); PG8_STAGE(PG8_SA(0, 1), a2 + hstep, voffA);
            PG8_WAIT_L(8); PG8_BAR; PG8_WAIT_L(0); PG8_MMA(0, 0, At, B0); PG8_BAR; PG8_SCHED;
            PG8_LDB(B1, 1, 1); PG8_STAGE(PG8_SB(1, 0), b3, voffB);
            PG8_BAR; PG8_WAIT_L(0); PG8_MMA(0, 1, At, B1); PG8_BAR;
            PG8_LDA(At, 1, 1); PG8_STAGE(PG8_SA(1, 0), a3, voffA);
            PG8_BAR; PG8_WAIT_L(0); PG8_MMA(1, 0, At, B0); PG8_BAR; PG8_SCHED;
            PG8_STAGE(PG8_SB(1, 1), b3 + hstep, voffB);
            PG8_WAIT_V(6); PG8_BAR; PG8_MMA(1, 1, At, B1); PG8_BAR;
            }
        }
        if constexpr (ALIGN_EPI) { if (wr == 0) PG8_BAR; }
        if constexpr (!Epi::AFTER_DRAIN) { E(acc, cur, wr, wc, fr, fq); S.done(cur); }
        if (!has_next) break;
#pragma unroll
        for (int a = 0; a < 2; ++a)
#pragma unroll
            for (int b = 0; b < 2; ++b)
#pragma unroll
                for (int m = 0; m < 4; ++m)
#pragma unroll
                    for (int n = 0; n < 2; ++n) acc[a][b][m][n] = (f32x4){0.f, 0.f, 0.f, 0.f};
        cur = nxt; cA = nA; cB = nB; ++ui;
        if constexpr (ALIGN_EPI) { if (wr == 1) PG8_BAR; }
    }
    PG8_WAIT_V(0);
    if constexpr (!ALIGN_EPI) { if (wr == 0) PG8_BAR; }
    PG8_BAR;
    if constexpr (Epi::AFTER_DRAIN) { E.fused(acc, cur, wr, wc, fr, fq, lds, wid, lane); S.done(cur); }
#undef PG8_SA
#undef PG8_SB
#undef PG8_STAGE
#undef PG8_LDA
#undef PG8_LDB
#undef PG8_MMA
#undef PG8_WAIT_V
#undef PG8_WAIT_L
#undef PG8_BAR
#undef PG8_SCHED
}
}
#define LAS __attribute__((address_space(3)))
using pg8::bf16_t; using pg8::bf16x8; using pg8::f32x4; using pg8::u32x4;
typedef short s16x4 __attribute__((ext_vector_type(4)));
typedef float f32x16 __attribute__((ext_vector_type(16)));
using pg8::u32x2;
typedef unsigned char uchar;

constexpr int BATCH = 8, SEQ = 4096, DM = 1024, DEPTH = 4, M = BATCH * SEQ, NIN = 3584, FF = 4096;
constexpr float EPS = 1e-6f, LOG2E = 1.4426950408889634f;
constexpr size_t MiB = 1u << 20;
constexpr size_t WS_W = 2 * MiB, W_LAYER = 25 * MiB, W_IN = 0, W_OUT = 7 * MiB, W_1 = 9 * MiB, W_2 = 17 * MiB;
constexpr size_t WS_XN = 104 * MiB;
constexpr size_t WS_MIX = 168 * MiB;
constexpr size_t WS_PROJ = 232 * MiB;
constexpr size_t SEC = 32 * MiB;
constexpr size_t WS_ST = 456 * MiB;
constexpr size_t WS_END = 504 * MiB;
constexpr int LDS_BYTES = 148480, MISC_OFF = 147456;
constexpr size_t WS_CTL = 0, WS_ROWSS = 488 * MiB, CTL_BYTES = 65536;
constexpr int NWAVES = 8;

__device__ __forceinline__ unsigned f2bf(float f) { unsigned u = __builtin_bit_cast(unsigned, f); return (u + 0x7fffu + ((u >> 16) & 1u)) >> 16; }
__device__ __forceinline__ unsigned pk2(float lo, float hi) { return pg8::cvt_pk_bf16(lo, hi); }
__device__ __forceinline__ float bflo(unsigned w) { return __builtin_bit_cast(float, w << 16); }
__device__ __forceinline__ float bfhi(unsigned w) { return __builtin_bit_cast(float, w & 0xffff0000u); }
__device__ __forceinline__ float wave_sum(float v) {
#pragma unroll
    for (int o = 1; o < 64; o <<= 1) v += __shfl_xor(v, o);
    return v;
}
__device__ __forceinline__ s16x4 tr16(const LAS uchar* p) { return __builtin_bit_cast(s16x4, __builtin_amdgcn_ds_read_tr16_b64_v4i16((LAS s16x4*)p)); }
__device__ __forceinline__ bf16x8 cat8(s16x4 lo, s16x4 hi) { return (bf16x8){lo[0], lo[1], lo[2], lo[3], hi[0], hi[1], hi[2], hi[3]}; }
#define LDS_WAIT() asm volatile("s_waitcnt lgkmcnt(0)" ::: "memory")

__device__ __forceinline__ void transpose_item(const float* W, int K, int N, bf16_t* WT, const float* gain, bool perm, LAS float* scr, int item, int lane) {
    const int nblk = N / 32, kb = item / nblk, nb = item % nblk, k0 = 64 * kb, n0 = 32 * nb;
    float wv[32];
#pragma unroll
    for (int i = 0; i < 32; ++i) { const int kk = 2 * i + (lane >> 5); wv[i] = __builtin_nontemporal_load(W + (size_t)(k0 + kk) * N + n0 + (lane & 31)); }
    if (gain) {
#pragma unroll
        for (int i = 0; i < 32; ++i) wv[i] *= gain[k0 + 2 * i + (lane >> 5)];
    }
#pragma unroll
    for (int i = 0; i < 32; ++i) { const int kk = 2 * i + (lane >> 5); scr[kk * 33 + (lane & 31)] = wv[i]; }
    LDS_WAIT(); asm volatile("" ::: "memory");
    int nrow0 = n0;
    if (perm) { const int o = nb & 7, wc = o >> 1, bj = o & 1; nrow0 = (nb & ~7) * 32 + (4 * bj + wc) * 32; }
    const int c = lane & 7;
#pragma unroll
    for (int j = 0; j < 4; ++j) { const int n = (lane >> 3) + 8 * j; const LAS float* s = scr + (8 * c) * 33 + n;
        u32x4 o; o.x = pk2(s[0 * 33], s[1 * 33]); o.y = pk2(s[2 * 33], s[3 * 33]); o.z = pk2(s[4 * 33], s[5 * 33]); o.w = pk2(s[6 * 33], s[7 * 33]);
        *(u32x4*)(WT + (size_t)(nrow0 + n) * K + k0 + 8 * c) = o; }
    LDS_WAIT(); asm volatile("" ::: "memory");
}
__device__ __forceinline__ void norm_rows(const float* x, bf16_t* xn, float* rowss, int gw, int ngw, int lane) {
    for (int m = gw; m < M; m += ngw) {
        const f32x4* xr = (const f32x4*)(x + (size_t)m * DM) + lane;
        f32x4 v[4]; float s = 0.f;
#pragma unroll
        for (int j = 0; j < 4; ++j) { v[j] = __builtin_nontemporal_load(xr + 64 * j); s += (v[j][0] * v[j][0] + v[j][1] * v[j][1]) + (v[j][2] * v[j][2] + v[j][3] * v[j][3]); }
        s = wave_sum(s);
        if (lane < 16) rowss[(size_t)m * 16 + lane] = lane == 0 ? s : 0.f;
        u32x2* o8 = (u32x2*)(xn + (size_t)m * DM) + lane;
#pragma unroll
        for (int j = 0; j < 4; ++j) { u32x2 w; w.x = pk2(v[j][0], v[j][1]); w.y = pk2(v[j][2], v[j][3]); o8[64 * j] = w; }
    }
}

constexpr int RRT_OFF = 131072;
__device__ __forceinline__ void fill_rrt(LAS uchar* lds, const float* part, int pm_base) {
    const int tid = fresh_tid();
    LAS float* rrt = (LAS float*)(lds + RRT_OFF);
#pragma unroll
    for (int i = 0; i < 8; ++i) { const int r = tid + i * 512; rrt[r] = 1.0f / sqrtf(pg8::row_ss(part, pm_base * 256 + r) * (1.0f / 1024.0f) + EPS); }
    __syncthreads();
}

constexpr int AKP = 272, AVP = 320, AKT = 64 * AKP, AVT = 64 * AVP, AVOFF = 2 * AKT;
static_assert(AVOFF + 3 * AVT <= 131072 && 65536 <= AVOFF + 3 * AVT, "attention LDS");
__device__ __forceinline__ void attn_unit(LAS uchar* lds, int b, int h, int qb, const bf16_t* DQ, const bf16_t* DK, const bf16_t* DV, bf16_t* MIX,
                                          float lam, float slope2, float B2, const float* og, float oscale, int tlo, int cnt) {
    const int tid = fresh_tid(), lane = tid & 63, wid = __builtin_amdgcn_readfirstlane(tid >> 6), comp = wid >> 2, qg = wid & 3, r32 = lane & 31, hh = lane >> 5;
    const size_t tok0 = (size_t)b * SEQ;
    const int qpos = qb * 128 + qg * 32 + r32;
    bf16x8 qf[4];
    { const bf16_t* qp = DQ + (tok0 + qpos) * 512 + h * 128 + comp * 64 + hh * 8;
#pragma unroll
      for (int kk = 0; kk < 4; ++kk) qf[kk] = *(const bf16x8*)(qp + 16 * kk); }
    const int srow = tid >> 4, sch = tid & 15;
    const bf16_t* kg = DK + (tok0 + srow) * 512 + h * 128 + sch * 8;
    const bf16_t* vg = DV + (tok0 + srow) * 512 + h * 128 + sch * 8;
    u32x4 kr0, kr1, vr0, vr1;
    const int t0 = qb * 2;
    unsigned kxo, kxj0, kxj1;
    { const unsigned j0 = f2bf((float)r32), j1 = f2bf((float)(r32 + 32)); kxo = hh ? 0u : 0x3f803f80u; kxj0 = hh ? 0u : (j0 | (j0 << 16)); kxj1 = hh ? 0u : (j1 | (j1 << 16)); }
    const int Q0 = qb * 128 + qg * 32;
#define A_GLOAD(t) do { const size_t o_ = (size_t)(t) * 64 * 512; kr0 = *(const u32x4*)(kg + o_); kr1 = *(const u32x4*)(kg + o_ + 32 * 512); vr0 = *(const u32x4*)(vg + o_); vr1 = *(const u32x4*)(vg + o_ + 32 * 512); } while (0)
#define SB_() __builtin_amdgcn_sched_barrier(0)
#define A_VLD(dst, c_) do { _Pragma("unroll") for (int k_ = 0; k_ < 4; ++k_) { dst[k_][0] = tr16(vp_ + (16 * (c_)) * AVP + k_ * 64); dst[k_][1] = tr16(vp_ + (16 * (c_) + 8) * AVP + k_ * 64); } } while (0)
#define A_VMM(src, c_) do { _Pragma("unroll") for (int k_ = 0; k_ < 4; ++k_) o[k_] = __builtin_amdgcn_mfma_f32_32x32x16_bf16(cat8(src[k_][0], src[k_][1]), pf[c_], o[k_], 0, 0, 0); } while (0)
#define A_PV(vbuf) do { const LAS uchar* vp_ = (vbuf) + (4 * hh + ((lane & 15) >> 2)) * AVP + ((lane >> 4) & 1) * 32 + (lane & 3) * 8; \
        s16x4 va_[4][2], vb_[4][2]; \
        SB_(); A_VLD(va_, 0); A_VLD(vb_, 1); SB_(); A_VMM(va_, 0); SB_(); A_VLD(va_, 2); SB_(); A_VMM(vb_, 1); SB_(); A_VLD(vb_, 3); SB_(); A_VMM(va_, 2); SB_(); A_VMM(vb_, 3); SB_(); } while (0)
    f32x16 o[4];
#pragma unroll
    for (int k = 0; k < 4; ++k)
#pragma unroll
        for (int i = 0; i < 16; ++i) o[k][i] = 0.f;
    bf16x8 pf[4];
#pragma unroll
    for (int k = 0; k < 4; ++k) pf[k] = (bf16x8){0, 0, 0, 0, 0, 0, 0, 0};
    float lsum = 0.f;
    A_GLOAD(t0);
    int trel = t0 - tlo, vcur = 0, vprev = 2;
    const LAS uchar* vfr = lds + AVOFF + (4 * hh + ((lane & 15) >> 2)) * AVP + ((lane >> 4) & 1) * 32 + (lane & 3) * 8;
    for (int it = 0; it < cnt; ++it) {
        const int t = tlo + trel;
        trel = (trel + 1 == cnt) ? 0 : trel + 1;
        LAS uchar* kb = lds + (it & 1) * AKT; LAS uchar* vb = lds + AVOFF + vcur * AVT;
        *(LAS u32x4*)(kb + srow * AKP + sch * 16) = kr0; *(LAS u32x4*)(kb + (srow + 32) * AKP + sch * 16) = kr1;
        *(LAS u32x4*)(vb + srow * AVP + sch * 16) = vr0; *(LAS u32x4*)(vb + (srow + 32) * AVP + sch * 16) = vr1;
        __syncthreads();
        if (it + 1 < cnt) { const int tn = tlo + trel; A_GLOAD(tn); }
        const LAS uchar* vp_ = vfr + vprev * AVT;
        s16x4 va_[4][2], vb_[4][2];
        if (it > 0) { A_VLD(va_, 0); }
        const bool general = it < 2;
        bf16x8 qx;
        { const float sg = (t > t0) ? 1.0f : -1.0f;
          const float av = general ? -B2 : sg * slope2 * (float)(r32 - (64 * t - Q0)) - B2, bv = general ? 0.f : -sg * slope2;
          const unsigned t1 = pk2(av, bv), t2 = pk2(av - bflo(t1), bv - bfhi(t1));
          u32x4 w; w.x = hh ? 0u : ((t1 & 0xffffu) | (t2 << 16)); w.y = hh ? 0u : ((t1 >> 16) | (t2 & 0xffff0000u)); w.z = 0u; w.w = 0u; qx = __builtin_bit_cast(bf16x8, w); }
        f32x16 s0, s1;
#pragma unroll
        for (int i = 0; i < 16; ++i) { s0[i] = 0.f; s1[i] = 0.f; }
        { const LAS uchar* kp = kb + r32 * AKP + comp * 128 + hh * 16;
          bf16x8 a0[4], a1[4];
#pragma unroll
          for (int kk = 0; kk < 4; ++kk) { a0[kk] = *(const LAS bf16x8*)(kp + kk * 32); a1[kk] = *(const LAS bf16x8*)(kp + 32 * AKP + kk * 32); }
          SB_();
          { unsigned ko_ = kxo, ka_ = kxj0, kb_ = kxj1; asm volatile("" : "+v"(ko_), "+v"(ka_), "+v"(kb_));
            s0 = __builtin_amdgcn_mfma_f32_32x32x16_bf16(__builtin_bit_cast(bf16x8, (u32x4){ko_, ka_, 0u, 0u}), qx, s0, 0, 0, 0);
            s1 = __builtin_amdgcn_mfma_f32_32x32x16_bf16(__builtin_bit_cast(bf16x8, (u32x4){ko_, kb_, 0u, 0u}), qx, s1, 0, 0, 0); }
#pragma unroll
          for (int kk = 0; kk < 4; ++kk) {
              s0 = __builtin_amdgcn_mfma_f32_32x32x16_bf16(a0[kk], qf[kk], s0, 0, 0, 0);
              s1 = __builtin_amdgcn_mfma_f32_32x32x16_bf16(a1[kk], qf[kk], s1, 0, 0, 0); } }
        if (general) {
            const float qk = (float)(qpos - t * 64 - 4 * hh);
#pragma unroll
            for (int i = 0; i < 16; ++i) { const float c = (float)(8 * (i >> 2) + (i & 3));
                s0[i] = __builtin_fmaf(-slope2, __builtin_fabsf(qk - c), s0[i]); s1[i] = __builtin_fmaf(-slope2, __builtin_fabsf(qk - (c + 32.f)), s1[i]); }
        }
        float ps = 0.f;
        u32x4 w0, w1, w2, w3;
        if (it > 0) {
            SB_();
            o[0] = __builtin_amdgcn_mfma_f32_32x32x16_bf16(cat8(va_[0][0], va_[0][1]), pf[0], o[0], 0, 0, 0); vb_[0][0] = tr16(vp_ + (16 * 1) * AVP + 0 * 64); vb_[0][1] = tr16(vp_ + (16 * 1 + 8) * AVP + 0 * 64); s0[0] = __builtin_amdgcn_exp2f(s0[0]); s1[0] = __builtin_amdgcn_exp2f(s1[0]); ps += s0[0] + s1[0]; SB_();
            o[1] = __builtin_amdgcn_mfma_f32_32x32x16_bf16(cat8(va_[1][0], va_[1][1]), pf[0], o[1], 0, 0, 0); vb_[1][0] = tr16(vp_ + (16 * 1) * AVP + 1 * 64); vb_[1][1] = tr16(vp_ + (16 * 1 + 8) * AVP + 1 * 64); s0[1] = __builtin_amdgcn_exp2f(s0[1]); s1[1] = __builtin_amdgcn_exp2f(s1[1]); ps += s0[1] + s1[1]; w0.x = pk2(s0[0], s0[1]); w2.x = pk2(s1[0], s1[1]); SB_();
            o[2] = __builtin_amdgcn_mfma_f32_32x32x16_bf16(cat8(va_[2][0], va_[2][1]), pf[0], o[2], 0, 0, 0); vb_[2][0] = tr16(vp_ + (16 * 1) * AVP + 2 * 64); vb_[2][1] = tr16(vp_ + (16 * 1 + 8) * AVP + 2 * 64); s0[2] = __builtin_amdgcn_exp2f(s0[2]); s1[2] = __builtin_amdgcn_exp2f(s1[2]); ps += s0[2] + s1[2]; SB_();
            o[3] = __builtin_amdgcn_mfma_f32_32x32x16_bf16(cat8(va_[3][0], va_[3][1]), pf[0], o[3], 0, 0, 0); vb_[3][0] = tr16(vp_ + (16 * 1) * AVP + 3 * 64); vb_[3][1] = tr16(vp_ + (16 * 1 + 8) * AVP + 3 * 64); s0[3] = __builtin_amdgcn_exp2f(s0[3]); s1[3] = __builtin_amdgcn_exp2f(s1[3]); ps += s0[3] + s1[3]; w0.y = pk2(s0[2], s0[3]); w2.y = pk2(s1[2], s1[3]); SB_();
            o[0] = __builtin_amdgcn_mfma_f32_32x32x16_bf16(cat8(vb_[0][0], vb_[0][1]), pf[1], o[0], 0, 0, 0); va_[0][0] = tr16(vp_ + (16 * 2) * AVP + 0 * 64); va_[0][1] = tr16(vp_ + (16 * 2 + 8) * AVP + 0 * 64); s0[4] = __builtin_amdgcn_exp2f(s0[4]); s1[4] = __builtin_amdgcn_exp2f(s1[4]); ps += s0[4] + s1[4]; SB_();
            o[1] = __builtin_amdgcn_mfma_f32_32x32x16_bf16(cat8(vb_[1][0], vb_[1][1]), pf[1], o[1], 0, 0, 0); va_[1][0] = tr16(vp_ + (16 * 2) * AVP + 1 * 64); va_[1][1] = tr16(vp_ + (16 * 2 + 8) * AVP + 1 * 64); s0[5] = __builtin_amdgcn_exp2f(s0[5]); s1[5] = __builtin_amdgcn_exp2f(s1[5]); ps += s0[5] + s1[5]; w0.z = pk2(s0[4], s0[5]); w2.z = pk2(s1[4], s1[5]); SB_();
            o[2] = __builtin_amdgcn_mfma_f32_32x32x16_bf16(cat8(vb_[2][0], vb_[2][1]), pf[1], o[2], 0, 0, 0); va_[2][0] = tr16(vp_ + (16 * 2) * AVP + 2 * 64); va_[2][1] = tr16(vp_ + (16 * 2 + 8) * AVP + 2 * 64); s0[6] = __builtin_amdgcn_exp2f(s0[6]); s1[6] = __builtin_amdgcn_exp2f(s1[6]); ps += s0[6] + s1[6]; SB_();
            o[3] = __builtin_amdgcn_mfma_f32_32x32x16_bf16(cat8(vb_[3][0], vb_[3][1]), pf[1], o[3], 0, 0, 0); va_[3][0] = tr16(vp_ + (16 * 2) * AVP + 3 * 64); va_[3][1] = tr16(vp_ + (16 * 2 + 8) * AVP + 3 * 64); s0[7] = __builtin_amdgcn_exp2f(s0[7]); s1[7] = __builtin_amdgcn_exp2f(s1[7]); ps += s0[7] + s1[7]; w0.w = pk2(s0[6], s0[7]); w2.w = pk2(s1[6], s1[7]); SB_();
            o[0] = __builtin_amdgcn_mfma_f32_32x32x16_bf16(cat8(va_[0][0], va_[0][1]), pf[2], o[0], 0, 0, 0); vb_[0][0] = tr16(vp_ + (16 * 3) * AVP + 0 * 64); vb_[0][1] = tr16(vp_ + (16 * 3 + 8) * AVP + 0 * 64); s0[8] = __builtin_amdgcn_exp2f(s0[8]); s1[8] = __builtin_amdgcn_exp2f(s1[8]); ps += s0[8] + s1[8]; SB_();
            o[1] = __builtin_amdgcn_mfma_f32_32x32x16_bf16(cat8(va_[1][0], va_[1][1]), pf[2], o[1], 0, 0, 0); vb_[1][0] = tr16(vp_ + (16 * 3) * AVP + 1 * 64); vb_[1][1] = tr16(vp_ + (16 * 3 + 8) * AVP + 1 * 64); s0[9] = __builtin_amdgcn_exp2f(s0[9]); s1[9] = __builtin_amdgcn_exp2f(s1[9]); ps += s0[9] + s1[9]; w1.x = pk2(s0[8], s0[9]); w3.x = pk2(s1[8], s1[9]); SB_();
            o[2] = __builtin_amdgcn_mfma_f32_32x32x16_bf16(cat8(va_[2][0], va_[2][1]), pf[2], o[2], 0, 0, 0); vb_[2][0] = tr16(vp_ + (16 * 3) * AVP + 2 * 64); vb_[2][1] = tr16(vp_ + (16 * 3 + 8) * AVP + 2 * 64); s0[10] = __builtin_amdgcn_exp2f(s0[10]); s1[10] = __builtin_amdgcn_exp2f(s1[10]); ps += s0[10] + s1[10]; SB_();
            o[3] = __builtin_amdgcn_mfma_f32_32x32x16_bf16(cat8(va_[3][0], va_[3][1]), pf[2], o[3], 0, 0, 0); vb_[3][0] = tr16(vp_ + (16 * 3) * AVP + 3 * 64); vb_[3][1] = tr16(vp_ + (16 * 3 + 8) * AVP + 3 * 64); s0[11] = __builtin_amdgcn_exp2f(s0[11]); s1[11] = __builtin_amdgcn_exp2f(s1[11]); ps += s0[11] + s1[11]; w1.y = pk2(s0[10], s0[11]); w3.y = pk2(s1[10], s1[11]); SB_();
            o[0] = __builtin_amdgcn_mfma_f32_32x32x16_bf16(cat8(vb_[0][0], vb_[0][1]), pf[3], o[0], 0, 0, 0); s0[12] = __builtin_amdgcn_exp2f(s0[12]); s1[12] = __builtin_amdgcn_exp2f(s1[12]); ps += s0[12] + s1[12]; SB_();
            o[1] = __builtin_amdgcn_mfma_f32_32x32x16_bf16(cat8(vb_[1][0], vb_[1][1]), pf[3], o[1], 0, 0, 0); s0[13] = __builtin_amdgcn_exp2f(s0[13]); s1[13] = __builtin_amdgcn_exp2f(s1[13]); ps += s0[13] + s1[13]; w1.z = pk2(s0[12], s0[13]); w3.z = pk2(s1[12], s1[13]); SB_();
            o[2] = __builtin_amdgcn_mfma_f32_32x32x16_bf16(cat8(vb_[2][0], vb_[2][1]), pf[3], o[2], 0, 0, 0); s0[14] = __builtin_amdgcn_exp2f(s0[14]); s1[14] = __builtin_amdgcn_exp2f(s1[14]); ps += s0[14] + s1[14]; SB_();
            o[3] = __builtin_amdgcn_mfma_f32_32x32x16_bf16(cat8(vb_[3][0], vb_[3][1]), pf[3], o[3], 0, 0, 0); s0[15] = __builtin_amdgcn_exp2f(s0[15]); s1[15] = __builtin_amdgcn_exp2f(s1[15]); ps += s0[15] + s1[15]; w1.w = pk2(s0[14], s0[15]); w3.w = pk2(s1[14], s1[15]); SB_();
        } else {
#pragma unroll
            for (int i = 0; i < 16; ++i) { s0[i] = __builtin_amdgcn_exp2f(s0[i]); s1[i] = __builtin_amdgcn_exp2f(s1[i]); ps += s0[i] + s1[i]; }
            w0.x = pk2(s0[0], s0[1]); w0.y = pk2(s0[2], s0[3]); w0.z = pk2(s0[4], s0[5]); w0.w = pk2(s0[6], s0[7]);
            w1.x = pk2(s0[8], s0[9]); w1.y = pk2(s0[10], s0[11]); w1.z = pk2(s0[12], s0[13]); w1.w = pk2(s0[14], s0[15]);
            w2.x = pk2(s1[0], s1[1]); w2.y = pk2(s1[2], s1[3]); w2.z = pk2(s1[4], s1[5]); w2.w = pk2(s1[6], s1[7]);
            w3.x = pk2(s1[8], s1[9]); w3.y = pk2(s1[10], s1[11]); w3.z = pk2(s1[12], s1[13]); w3.w = pk2(s1[14], s1[15]);
        }
        lsum += ps;
        pf[0] = __builtin_bit_cast(bf16x8, w0); pf[1] = __builtin_bit_cast(bf16x8, w1); pf[2] = __builtin_bit_cast(bf16x8, w2); pf[3] = __builtin_bit_cast(bf16x8, w3);
        vprev = vcur; vcur = (vcur == 2) ? 0 : vcur + 1;
    }
    A_PV(lds + AVOFF + vprev * AVT);
#undef A_GLOAD
#undef A_PV
#undef A_VLD
#undef A_VMM
#undef SB_
    { const auto rr_ = __builtin_amdgcn_permlane32_swap(__float_as_uint(lsum), __float_as_uint(lsum), false, false); lsum = __uint_as_float(rr_[0]) + __uint_as_float(rr_[1]); }
    const float inv = 1.0f / lsum;
    LAS float* X = (LAS float*)lds + qg * 4096 + lane;
    __syncthreads();
    if (comp == 1) {
#pragma unroll
        for (int k = 0; k < 4; ++k)
#pragma unroll
            for (int i = 0; i < 16; ++i) X[(k * 16 + i) * 64] = o[k][i] * inv;
    }
    __syncthreads();
    if (comp == 0) {
        float ss = 0.f;
#pragma unroll
        for (int k = 0; k < 4; ++k)
#pragma unroll
            for (int i = 0; i < 16; ++i) { const float a = o[k][i] * inv - lam * X[(k * 16 + i) * 64]; o[k][i] = a; ss += a * a; }
        { const auto rr_ = __builtin_amdgcn_permlane32_swap(__float_as_uint(ss), __float_as_uint(ss), false, false); ss = __uint_as_float(rr_[0]) + __uint_as_float(rr_[1]); }
        const float r = oscale / sqrtf(ss * (1.0f / 128.0f) + EPS);
        bf16_t* mp = MIX + (tok0 + qpos) * 1024 + h * 128 + 4 * hh;
#pragma unroll
        for (int k = 0; k < 4; ++k)
#pragma unroll
            for (int q4 = 0; q4 < 4; ++q4) {
                const int dv = 32 * k + 8 * q4; const f32x4 g = *(const f32x4*)(og + dv + 4 * hh);
                u32x2 w; w.x = pk2(o[k][4 * q4] * r * g[0], o[k][4 * q4 + 1] * r * g[1]); w.y = pk2(o[k][4 * q4 + 2] * r * g[2], o[k][4 * q4 + 3] * r * g[3]);
                *(u32x2*)(mp + dv) = w; }
    }
    __syncthreads();
}

constexpr int RPR = 144, RPV = 160;
__device__ __forceinline__ bf16x8 trpair(const LAS uchar* p) { return cat8(tr16(p), tr16(p + 16 * RPV)); }
__device__ __forceinline__ u32x4 scale8(u32x4 v, float w) {
    u32x4 o; o.x = pk2(bflo(v.x) * w, bfhi(v.x) * w); o.y = pk2(bflo(v.y) * w, bfhi(v.y) * w); o.z = pk2(bflo(v.z) * w, bfhi(v.z) * w); o.w = pk2(bflo(v.w) * w, bfhi(v.w) * w); return o;
}
__device__ __forceinline__ void r1_phase(LAS uchar* lds, int vcu, int G, const bf16_t* RK, const bf16_t* RV, float* KV, const float* dec_f, const float* dec_b) {
    const int tid = fresh_tid(), lane = tid & 63, wid = __builtin_amdgcn_readfirstlane(tid >> 6);
    LAS uchar* KF = lds; LAS uchar* KB = lds + 128 * RPV; LAS uchar* V = lds + 256 * RPV;
    u32x4 k8[2], v8[2];
#define R1_LOAD(u_) do { const int bh_ = (u_) >> 5, n_ = (u_) & 31; _Pragma("unroll") for (int i_ = 0; i_ < 2; ++i_) { const int p_ = tid + i_ * 512; \
        const size_t go_ = ((size_t)(bh_ >> 3) * SEQ + n_ * 128 + (p_ >> 3)) * 512 + (bh_ & 7) * 64 + (p_ & 7) * 8; k8[i_] = *(const u32x4*)(RK + go_); v8[i_] = *(const u32x4*)(RV + go_); } } while (0)
    int u = vcu;
    if (u < 2048) R1_LOAD(u);
    for (; u < 2048; u += G) {
        const int bh = u >> 5, n = u & 31, h = bh & 7;
        const float lgf2 = -log1pf(expf(-dec_f[h])) * LOG2E, lgb2 = -log1pf(expf(-dec_b[h])) * LOG2E;
#pragma unroll
        for (int i = 0; i < 2; ++i) {
            const int p = tid + i * 512, j = p >> 3, ch = p & 7;
            const float wf = __builtin_amdgcn_exp2f(lgf2 * (float)(127 - j)), wb = __builtin_amdgcn_exp2f(lgb2 * (float)j);
            *(LAS u32x4*)(KF + j * RPV + ch * 16) = scale8(k8[i], wf);
            *(LAS u32x4*)(KB + j * RPV + ch * 16) = scale8(k8[i], wb);
            *(LAS u32x4*)(V + j * RPV + ch * 16) = v8[i];
        }
        __syncthreads();
        if (u + G < 2048) R1_LOAD(u + G);
        const int dir = wid >> 2, eb = wid & 3, kq = lane >> 4, il = lane & 15, r = il >> 2, cc = il & 3;
        const LAS uchar* vA = V + (4 * kq + r) * RPV + (16 * eb + 4 * cc) * 2;
        const LAS uchar* kB = (dir ? KB : KF) + (4 * kq + r) * RPV + (4 * cc) * 2;
        f32x4 acc[4];
#pragma unroll
        for (int d = 0; d < 4; ++d) acc[d] = (f32x4){0.f, 0.f, 0.f, 0.f};
#pragma unroll
        for (int jc = 0; jc < 4; ++jc) {
            const bf16x8 A = trpair(vA + 32 * jc * RPV);
#pragma unroll
            for (int db = 0; db < 4; ++db) { const bf16x8 B = trpair(kB + 32 * jc * RPV + db * 32); acc[db] = __builtin_amdgcn_mfma_f32_16x16x32_bf16(A, B, acc[db], 0, 0, 0); }
        }
        float* dst = KV + ((size_t)(bh * 32 + n) * 2 + dir) * 4096 + (16 * eb + 4 * kq) * 64 + il;
#pragma unroll
        for (int db = 0; db < 4; ++db)
#pragma unroll
            for (int v = 0; v < 4; ++v) dst[v * 64 + 16 * db] = acc[db][v];
        __syncthreads();
    }
#undef R1_LOAD
}
__device__ __forceinline__ void r2_item(int item, const float* KV, bf16_t* ST, const float* dec_f, const float* dec_b) {
    const int e4 = item & 1023, dir = (item >> 10) & 1, bh = item >> 11, h = bh & 7;
    const float x = dir ? dec_b[h] : dec_f[h];
    const float g = expf(-128.0f * log1pf(expf(-x)));
    f32x4 S = (f32x4){0.f, 0.f, 0.f, 0.f};
    for (int s = 0; s < 32; ++s) {
        const int n = dir ? 31 - s : s;
        const size_t off = ((size_t)(bh * 32 + n) * 2 + dir) * 4096 + e4 * 4;
        u32x2 w; w.x = pk2(S[0], S[1]); w.y = pk2(S[2], S[3]);
        *(u32x2*)(ST + off) = w;
        const f32x4 kv = __builtin_nontemporal_load((const f32x4*)(KV + off));
        S = S * g + kv;
    }
}
__device__ __forceinline__ void r3_phase(LAS uchar* lds, int vcu, int G, const bf16_t* RQ, const bf16_t* RK, const bf16_t* RV, const bf16_t* RG, const bf16_t* ST, bf16_t* MIX,
                                         const float* gng_l, const float* dec_f, const float* dec_b) {
    const int tid = fresh_tid(), lane = tid & 63, wid = __builtin_amdgcn_readfirstlane(tid >> 6);
    LAS uchar* K = lds; LAS uchar* V = lds + 128 * RPR; LAS uchar* SF = V + 128 * RPV; LAS uchar* SB = SF + 64 * RPR;
    const int il = lane & 15, kq = lane >> 4, r = il >> 2, cc = il & 3;
    const int ic = 16 * wid + il;
    u32x4 k8[2], v8[2], sf8, sb8; bf16x8 qf[2]; u32x2 gw[4];
#define R3_LOAD(u_) do { const int bh_ = (u_) >> 5, n_ = (u_) & 31, b_ = bh_ >> 3, h_ = bh_ & 7; _Pragma("unroll") for (int i_ = 0; i_ < 2; ++i_) { const int p_ = tid + i_ * 512; \
        const size_t go_ = ((size_t)b_ * SEQ + n_ * 128 + (p_ >> 3)) * 512 + h_ * 64 + (p_ & 7) * 8; k8[i_] = __builtin_nontemporal_load((const u32x4*)(RK + go_)); v8[i_] = __builtin_nontemporal_load((const u32x4*)(RV + go_)); } \
        { const bf16_t* sp_ = ST + ((size_t)(bh_ * 32 + n_) * 2) * 4096 + (tid >> 3) * 64 + (tid & 7) * 8; sf8 = __builtin_nontemporal_load((const u32x4*)(sp_)); sb8 = __builtin_nontemporal_load((const u32x4*)(sp_ + 4096)); } \
        { const size_t tk_ = ((size_t)b_ * SEQ + n_ * 128 + ic) * 512 + h_ * 64; qf[0] = __builtin_nontemporal_load((const bf16x8*)(RQ + tk_ + 8 * kq)); qf[1] = __builtin_nontemporal_load((const bf16x8*)(RQ + tk_ + 32 + 8 * kq)); \
          _Pragma("unroll") for (int eb_ = 0; eb_ < 4; ++eb_) gw[eb_] = __builtin_nontemporal_load((const u32x2*)(RG + tk_ + 16 * eb_ + 4 * kq)); } } while (0)
    int u = vcu;
    if (u < 2048) R3_LOAD(u);
    for (; u < 2048; u += G) {
        const int bh = u >> 5, n = u & 31, b = bh >> 3, h = bh & 7;
        const float lgf2 = -log1pf(expf(-dec_f[h])) * LOG2E, lgb2 = -log1pf(expf(-dec_b[h])) * LOG2E;
        const float* gng = gng_l + h * 64;
#pragma unroll
        for (int i = 0; i < 2; ++i) { const int p = tid + i * 512, j = p >> 3, ch = p & 7; *(LAS u32x4*)(K + j * RPR + ch * 16) = k8[i]; *(LAS u32x4*)(V + j * RPV + ch * 16) = v8[i]; }
        { const int e = tid >> 3, ch = tid & 7; *(LAS u32x4*)(SF + e * RPR + ch * 16) = sf8; *(LAS u32x4*)(SB + e * RPR + ch * 16) = sb8; }
        const bf16x8 q0 = qf[0], q1 = qf[1]; const u32x2 g0_ = gw[0], g1_ = gw[1], g2_ = gw[2], g3_ = gw[3];
        __syncthreads();
        if (u + G < 2048) R3_LOAD(u + G);
        const size_t tok = (size_t)b * SEQ + n * 128 + ic;
        f32x4 s[8];
#pragma unroll
        for (int jb = 0; jb < 8; ++jb) {
            s[jb] = (f32x4){0.f, 0.f, 0.f, 0.f};
            { const bf16x8 A0 = *(const LAS bf16x8*)(K + (16 * jb + il) * RPR + (8 * kq) * 2), A1 = *(const LAS bf16x8*)(K + (16 * jb + il) * RPR + (32 + 8 * kq) * 2);
              s[jb] = __builtin_amdgcn_mfma_f32_16x16x32_bf16(A0, q0, s[jb], 0, 0, 0); s[jb] = __builtin_amdgcn_mfma_f32_16x16x32_bf16(A1, q1, s[jb], 0, 0, 0); }
#pragma unroll
            for (int v = 0; v < 4; ++v) { const float d = (float)(ic - (16 * jb + 4 * kq + v)); const float w = __builtin_amdgcn_exp2f((d >= 0.f ? lgf2 : -lgb2) * d); s[jb][v] *= w; }
        }
        bf16x8 pf[4];
#pragma unroll
        for (int jc = 0; jc < 4; ++jc) { u32x4 w; w.x = pk2(s[2 * jc][0], s[2 * jc][1]); w.y = pk2(s[2 * jc][2], s[2 * jc][3]); w.z = pk2(s[2 * jc + 1][0], s[2 * jc + 1][1]); w.w = pk2(s[2 * jc + 1][2], s[2 * jc + 1][3]); pf[jc] = __builtin_bit_cast(bf16x8, w); }
        const float cf = __builtin_amdgcn_exp2f(lgf2 * (float)(ic + 1)), cb = __builtin_amdgcn_exp2f(lgb2 * (float)(128 - ic));
        f32x4 y[4];
        const LAS uchar* vA = V + (4 * kq + r) * RPV + (4 * cc) * 2;
        float sum = 0.f;
#pragma unroll
        for (int eb = 0; eb < 4; ++eb) {
            f32x4 a = (f32x4){0.f, 0.f, 0.f, 0.f}, af = a, ab = a;
#pragma unroll
            for (int jc = 0; jc < 4; ++jc) a = __builtin_amdgcn_mfma_f32_16x16x32_bf16(trpair(vA + 32 * jc * RPV + eb * 32), pf[jc], a, 0, 0, 0);
            { const bf16x8 Af0 = *(const LAS bf16x8*)(SF + (16 * eb + il) * RPR + (8 * kq) * 2), Af1 = *(const LAS bf16x8*)(SF + (16 * eb + il) * RPR + (32 + 8 * kq) * 2);
              const bf16x8 Ab0 = *(const LAS bf16x8*)(SB + (16 * eb + il) * RPR + (8 * kq) * 2), Ab1 = *(const LAS bf16x8*)(SB + (16 * eb + il) * RPR + (32 + 8 * kq) * 2);
              af = __builtin_amdgcn_mfma_f32_16x16x32_bf16(Af0, q0, af, 0, 0, 0); af = __builtin_amdgcn_mfma_f32_16x16x32_bf16(Af1, q1, af, 0, 0, 0);
              ab = __builtin_amdgcn_mfma_f32_16x16x32_bf16(Ab0, q0, ab, 0, 0, 0); ab = __builtin_amdgcn_mfma_f32_16x16x32_bf16(Ab1, q1, ab, 0, 0, 0); }
            y[eb] = a + af * cf + ab * cb;
            sum += (y[eb][0] + y[eb][1]) + (y[eb][2] + y[eb][3]);
        }
        sum += __shfl_xor(sum, 16); sum += __shfl_xor(sum, 32);
        const float mean = sum * (1.0f / 64.0f);
        float q = 0.f;
#pragma unroll
        for (int eb = 0; eb < 4; ++eb) { y[eb] = y[eb] - mean; q += (y[eb][0] * y[eb][0] + y[eb][1] * y[eb][1]) + (y[eb][2] * y[eb][2] + y[eb][3] * y[eb][3]); }
        q += __shfl_xor(q, 16); q += __shfl_xor(q, 32);
        const float rstd = 1.0f / sqrtf(q * (1.0f / 64.0f) + EPS);
#pragma unroll
        for (int eb = 0; eb < 4; ++eb) {
            const int e0 = 16 * eb + 4 * kq;
            const u32x2 gwv = eb == 0 ? g0_ : eb == 1 ? g1_ : eb == 2 ? g2_ : g3_;
            const f32x4 gn = *(const f32x4*)(gng + e0);
            const float g0 = bflo(gwv.x), g1 = bfhi(gwv.x), g2 = bflo(gwv.y), g3 = bfhi(gwv.y);
            const float o0 = y[eb][0] * rstd * gn[0] * g0 / (1.0f + __expf(-g0)), o1 = y[eb][1] * rstd * gn[1] * g1 / (1.0f + __expf(-g1));
            const float o2 = y[eb][2] * rstd * gn[2] * g2 / (1.0f + __expf(-g2)), o3 = y[eb][3] * rstd * gn[3] * g3 / (1.0f + __expf(-g3));
            u32x2 w; w.x = pk2(o0, o1); w.y = pk2(o2, o3);
            *(u32x2*)(MIX + tok * 1024 + 512 + h * 64 + e0) = w;
        }
        __syncthreads();
    }
#undef R3_LOAD
}

#define XB_TMO      128
#define XB_XCNT(j)  (256  + 64 * (j))
#define XB_XSUB(j)  (1280 + 64 * (j))
#define XB_XGEN(j)  (2304 + 64 * (j))
#define XB_TOP      3328
#define XB_TOPGEN   3392
#define XCD_BAR_WORDS 3456
#define XB_SPIN_CAP (1u << 18)

__device__ __forceinline__ unsigned xb_ld(unsigned* p)              { return __hip_atomic_load(p, __ATOMIC_RELAXED, __HIP_MEMORY_SCOPE_AGENT); }
__device__ __forceinline__ unsigned xb_add(unsigned* p, unsigned v) { return __hip_atomic_fetch_add(p, v, __ATOMIC_RELAXED, __HIP_MEMORY_SCOPE_AGENT); }
__device__ __forceinline__ unsigned xb_xcc_id() { return (unsigned)__builtin_amdgcn_s_getreg((3 << 11) | 20) & 0xFu; }
#define XB_SPIN(cond, bar) do { unsigned _sp = 0; while (cond) { __builtin_amdgcn_s_sleep(1); \
    if ((++_sp & 255u) == 0u) { if (xb_ld(&(bar)[XB_TMO])) break; if (_sp > XB_SPIN_CAP) { atomicAdd(&(bar)[XB_TMO], 1u); break; } } } } while (0)

struct XcdBarrier {
    unsigned* bar; unsigned x;
    volatile LAS unsigned* st;
};

__device__ __forceinline__ XcdBarrier xcd_barrier_post(unsigned* bar, volatile LAS unsigned* st) {
    XcdBarrier b; b.bar = bar; b.x = xb_xcc_id(); b.st = st;
    if (threadIdx.x == 0) (void)xb_add(&bar[XB_XCNT(b.x)], 1u);
    return b;
}
__device__ __forceinline__ void xcd_barrier_complete(unsigned* bar, unsigned x, unsigned& nloc, unsigned& nx) {
    const unsigned G = gridDim.x * gridDim.y * gridDim.z;
    unsigned sum, cnt, mine, sp = 0u;
    for (;;) {
        sum = 0u; cnt = 0u; mine = 0u;
#pragma unroll
        for (unsigned j = 0; j < 16; ++j) { const unsigned c = xb_ld(&bar[XB_XCNT(j)]); sum += c; cnt += (c > 0u) ? 1u : 0u; mine = (j == x) ? c : mine; }
        if (sum == G) break;
        __builtin_amdgcn_s_sleep(1);
        if ((++sp & 255u) == 0u) { if (xb_ld(&bar[XB_TMO])) break; if (sp > XB_SPIN_CAP) { atomicAdd(&bar[XB_TMO], 1u); break; } }
    }
    nloc = mine > 0u ? mine : 1u; nx = cnt > 0u ? cnt : 1u;
}

__device__ __forceinline__ void xcd_barrier(const XcdBarrier& b) {
    asm volatile("s_waitcnt vmcnt(0)" ::: "memory");
    __syncthreads();
    if (threadIdx.x == 0) {
        unsigned* bar = b.bar;
        __builtin_amdgcn_s_waitcnt(0);
        unsigned nloc = b.st[0], nx = b.st[1];
        if (nloc == 0u) { xcd_barrier_complete(bar, b.x, nloc, nx); b.st[0] = nloc; b.st[1] = nx; }
        const unsigned old = xb_add(&bar[XB_XSUB(b.x)], 1u);
        const unsigned gen = old / nloc;
        if (old + 1u == (gen + 1u) * nloc) {
            __builtin_amdgcn_fence(__ATOMIC_RELEASE, "agent");
            asm volatile("s_waitcnt vmcnt(0)" ::: "memory");
            const unsigned og = xb_add(&bar[XB_TOP], 1u);
            const unsigned tg = og / nx;
            if (og + 1u == (tg + 1u) * nx) xb_add(&bar[XB_TOPGEN], 1u);
            else XB_SPIN(xb_ld(&bar[XB_TOPGEN]) == tg, bar);
            __builtin_amdgcn_fence(__ATOMIC_ACQUIRE, "agent");
            xb_add(&bar[XB_XGEN(b.x)], 1u);
            asm volatile("s_waitcnt vmcnt(0)" ::: "memory");
        } else {
            XB_SPIN(xb_ld(&bar[XB_XGEN(b.x)]) == gen, bar);
            __builtin_amdgcn_fence(__ATOMIC_ACQUIRE, "agent");
            asm volatile("s_waitcnt vmcnt(0)" ::: "memory");
        }
    }
    __syncthreads();
}

#ifndef PHMASK
#define PHMASK 0x3ff
#endif
#define PHM(i) (((PHMASK) >> (i)) & 1)
struct Args { const float* in[17]; float* out; uchar* ws; int ph_lo, ph_hi; };
constexpr int PH_PER_LAYER = 7, N_PHASES = 1 + DEPTH * PH_PER_LAYER;

__global__ void __launch_bounds__(NWAVES * 64, 2) mk_fwd(Args args) {
    extern __shared__ __attribute__((aligned(16))) uchar lds_raw[];
    LAS uchar* lds = (LAS uchar*)lds_raw;
    cg::grid_group grid = cg::this_grid();
    for (int u = threadIdx.x; u < 64; u += NWAVES * 64) ((LAS unsigned*)(lds + MISC_OFF))[u] = 0u;
    __syncthreads();
    XcdBarrier bar = xcd_barrier_post((unsigned*)(args.ws + WS_CTL), (volatile LAS unsigned*)(lds + MISC_OFF) + 8);
    for (int p = args.ph_lo; p < args.ph_hi; ++p) {
        const int tid = fresh_tid(), lane = tid & 63, wave = __builtin_amdgcn_readfirstlane(tid >> 6);
        int G = gridDim.x, bx = blockIdx.x; asm volatile("" : "+s"(G), "+s"(bx));
        const int vcu = (G % 8 == 0) ? (bx % 8) * (G / 8) + bx / 8 : bx;
        const int gw = vcu * NWAVES + wave, ngw = G * NWAVES;
        __attribute__((address_space(1))) uchar* wsg = (__attribute__((address_space(1))) uchar*)args.ws; asm volatile("" : "+s"(wsg)); uchar* ws = (uchar*)wsg;
        const float* x_in = args.in[0];
        float* out = args.out;
        bf16_t* XN = (bf16_t*)(ws + WS_XN); bf16_t* MIX = (bf16_t*)(ws + WS_MIX); bf16_t* PROJ = (bf16_t*)(ws + WS_PROJ); bf16_t* HB = (bf16_t*)(ws + WS_PROJ);
        float* KV = (float*)(ws + WS_MIX); bf16_t* ST = (bf16_t*)(ws + WS_ST); float* ROWSS = (float*)(ws + WS_ROWSS);
        const bf16_t* DQ = PROJ; const bf16_t* DK = PROJ + SEC / 2; const bf16_t* DV = PROJ + 2 * (SEC / 2);
        const bf16_t* RQ = PROJ + 3 * (SEC / 2); const bf16_t* RK = PROJ + 4 * (SEC / 2); const bf16_t* RV = PROJ + 5 * (SEC / 2); const bf16_t* RG = PROJ + 6 * (SEC / 2);
        if (PHM(0) && p == 0) {
            LAS float* scr = (LAS float*)(lds + wave * 16384);
            constexpr int I_IN = (DM / 64) * (NIN / 32), I_OUT = (DM / 64) * (DM / 32), I_1 = (DM / 64) * (FF / 32), I_2 = (FF / 64) * (DM / 32), I_L = I_IN + I_OUT + I_1 + I_2;
            for (int it = gw; it < DEPTH * I_L; it += ngw) {
                const int l = it / I_L; int r = it % I_L;
                bf16_t* wl = (bf16_t*)(ws + WS_W + (size_t)l * W_LAYER);
                if (r < I_IN) { transpose_item(args.in[2] + (size_t)l * DM * NIN, DM, NIN, (bf16_t*)((uchar*)wl + W_IN), args.in[1] + l * DM, true, scr, r, lane); continue; } r -= I_IN;
                if (r < I_OUT) { transpose_item(args.in[13] + (size_t)l * DM * DM, DM, DM, (bf16_t*)((uchar*)wl + W_OUT), nullptr, false, scr, r, lane); continue; } r -= I_OUT;
                if (r < I_1) { transpose_item(args.in[15] + (size_t)l * DM * FF, DM, FF, (bf16_t*)((uchar*)wl + W_1), args.in[14] + l * DM, false, scr, r, lane); continue; } r -= I_1;
                transpose_item(args.in[16] + (size_t)l * FF * DM, FF, DM, (bf16_t*)((uchar*)wl + W_2), nullptr, false, scr, r, lane);
            }
            norm_rows(x_in, XN, ROWSS, gw, ngw, lane);
        } else {
            const int l = (p - 1) / PH_PER_LAYER, k = (p - 1) % PH_PER_LAYER;
            const uchar* wl = ws + WS_W + (size_t)l * W_LAYER;
            if (PHM(1) && k == 0) {
                pg8::Gemm g{XN, (const bf16_t*)(wl + W_IN), M, NIN, DM}; pg8::StaticOrder S; S.init(M, NIN, G, bx);
                { pg8::Unit u0; S.next(0, u0); fill_rrt(lds, ROWSS + (size_t)(2 * l) * M * 16, u0.pm & ~15); }
                pg8::EpiProj E{PROJ, SEC / 2, args.in[3] + l * 64, args.in[4] + l * 64, (const LAS float*)(lds + RRT_OFF)};
                pg8::gemm_phase<pg8::EpiProj, pg8::StaticOrder, true, true>(lds, g, S, E);
            } else if (PHM(2) && k == 1) {
                r1_phase(lds, vcu, G, RK, RV, KV, args.in[10] + l * 8, args.in[11] + l * 8);
            } else if (PHM(3) && k == 2) {
                for (int it = vcu * 512 + tid; it < 64 * 2 * 1024; it += G * 512) r2_item(it, KV, ST, args.in[10] + l * 8, args.in[11] + l * 8);
            } else if (PHM(4) && k == 3) {
                const float lam_init = 0.8f - 0.6f * expf(-0.3f * (float)l);
                const int per = G / 8 > 0 ? G / 8 : 1;
                if (vcu & 1) { r3_phase(lds, vcu, G, RQ, RK, RV, RG, ST, MIX, args.in[12] + l * 512, args.in[10] + l * 8, args.in[11] + l * 8); __syncthreads(); }
                if (PHM(8)) for (int u = vcu; u < 1024; u += G) {
                    int bh, qb;
                    if (G == 256) { const int xc = vcu >> 5, c = vcu & 31, i = u / G; bh = xc * 4 + i; qb = (i == 1) ? ((c + 16) & 31) : c; } else { bh = u >> 5; qb = u & 31; }
                    const int b = bh >> 2, h = bh & 3;
                    const float s1 = wave_sum(args.in[5][(l * 4 + h) * 64 + lane] * args.in[6][(l * 4 + h) * 64 + lane]);
                    const float s2 = wave_sum(args.in[7][(l * 4 + h) * 64 + lane] * args.in[8][(l * 4 + h) * 64 + lane]);
                    const float lam = expf(s1) - expf(s2) + lam_init;
                    const float slope = exp2f(-2.0f * (float)(h + 1));
                    float gq = fabsf(args.in[3][l * 64 + lane]), gk = fabsf(args.in[4][l * 64 + lane]);
#pragma unroll
                    for (int o_ = 1; o_ < 64; o_ <<= 1) { gq = fmaxf(gq, __shfl_xor(gq, o_)); gk = fmaxf(gk, __shfl_xor(gk, o_)); }
                    const float wf_ = (2.0f * 8.0f * gq * gk + 110.0f) / slope;
                    const int Wi = wf_ < 1.0e6f ? (int)wf_ + 1 : 1000000;
                    int tlo = (qb * 128 - Wi) >> 6; if (tlo < 0) tlo = 0;
                    int thi = (qb * 128 + 127 + Wi) >> 6; if (thi > SEQ / 64 - 1) thi = SEQ / 64 - 1;
                    tlo = __builtin_amdgcn_readfirstlane(tlo); thi = __builtin_amdgcn_readfirstlane(thi);
                    attn_unit(lds, b, h, qb, DQ, DK, DV, MIX, lam, slope * LOG2E, 8.0f * gq * gk * LOG2E * 1.01f + 0.5f, args.in[9] + l * 512 + h * 128, 1.0f - lam_init, tlo, thi - tlo + 1);
                }
                (void)per;
                __syncthreads();
                if (!(vcu & 1)) r3_phase(lds, vcu, G, RQ, RK, RV, RG, ST, MIX, args.in[12] + l * 512, args.in[10] + l * 8, args.in[11] + l * 8);
            } else if (PHM(5) && (k == 4 || k == 6)) {
                pg8::Gemm g = (k == 4) ? pg8::Gemm{MIX, (const bf16_t*)(wl + W_OUT), M, DM, DM} : pg8::Gemm{HB, (const bf16_t*)(wl + W_2), M, DM, FF};
                pg8::StaticOrder S; S.init(M, DM, G, bx, 1);
                const bool has_next = (k == 4) || (l + 1 < DEPTH);
                pg8::EpiRes E{XN, has_next ? nullptr : out, DM, ROWSS + (size_t)(k == 4 ? 2 * l + 1 : 2 * l + 2) * M * 16};
                pg8::gemm_phase<pg8::EpiRes, pg8::StaticOrder, true, true>(lds, g, S, E);
            } else if (PHM(7) && k == 5) {
                pg8::Gemm g{XN, (const bf16_t*)(wl + W_1), M, FF, DM}; pg8::StaticOrder S; S.init(M, FF, G, bx);
                { pg8::Unit u0; S.next(0, u0); fill_rrt(lds, ROWSS + (size_t)(2 * l + 1) * M * 16, u0.pm & ~15); }
                pg8::EpiRelu2 E{HB, FF, (const LAS float*)(lds + RRT_OFF)};
                pg8::gemm_phase<pg8::EpiRelu2, pg8::StaticOrder, true, true>(lds, g, S, E);
            }
        }
        if (p + 1 < args.ph_hi) { if (p == args.ph_lo) grid.sync(); else xcd_barrier(bar); }
    }
}

extern "C" void kernel_launch(void* const* d_in, const int* in_sizes, int n_in, void* d_out, int out_size, void* d_ws, size_t ws_size, hipStream_t stream) {
    static int grid = 0;
    if (grid == 0) {
        if (n_in != 17 || out_size != M * DM || ws_size < WS_END) { fprintf(stderr, "kernel_launch: unexpected shapes (n_in %d out %d ws %zu)\n", n_in, out_size, ws_size); grid = -1; return; }
        int dev = 0, cus = 0, per_cu = 0;
        hipGetDevice(&dev); hipDeviceGetAttribute(&cus, hipDeviceAttributeMultiprocessorCount, dev);
        if (hipFuncSetAttribute((const void*)mk_fwd, hipFuncAttributeMaxDynamicSharedMemorySize, LDS_BYTES) != hipSuccess) { fprintf(stderr, "kernel_launch: hipFuncSetAttribute failed\n"); grid = -1; return; }
        hipOccupancyMaxActiveBlocksPerMultiprocessor(&per_cu, (const void*)mk_fwd, NWAVES * 64, LDS_BYTES);
        (void)hipGetLastError();
        if (per_cu < 1) per_cu = 1;
        grid = cus * per_cu;
        fprintf(stderr, "kernel_launch: cus %d per_cu %d grid %d\n", cus, per_cu, grid);
    }
    if (grid < 0) return;
    if (hipMemsetAsync((char*)d_ws + WS_CTL, 0, CTL_BYTES, stream) != hipSuccess) { fprintf(stderr, "kernel_launch: memset failed\n"); return; }
    Args a{};
    for (int i = 0; i < 17; ++i) a.in[i] = (const float*)d_in[i];
    a.out = (float*)d_out; a.ws = (uchar*)d_ws;
#ifndef MK_MULTI
    a.ph_lo = 0; a.ph_hi = N_PHASES;
    void* kargs[] = {&a};
    hipError_t e = hipLaunchCooperativeKernel((const void*)mk_fwd, dim3(grid), dim3(NWAVES * 64), kargs, LDS_BYTES, stream);
    if (e != hipSuccess) fprintf(stderr, "cooperative launch failed: %s (grid %d)\n", hipGetErrorString(e), grid);
#else
    for (int p = 0; p < N_PHASES; ++p) { a.ph_lo = p; a.ph_hi = p + 1; hipLaunchKernelGGL(mk_fwd, dim3(grid), dim3(NWAVES * 64), LDS_BYTES, stream, a); }
#endif
}
```

```cpp
#include <hip/hip_runtime.h>
#include <hip/hip_cooperative_groups.h>
#include <cstdio>
#include <cstdint>
namespace cg = cooperative_groups;
__device__ __forceinline__ int fresh_tid() { int t = threadIdx.x; asm volatile("" : "+v"(t)); return t; }
namespace pg8 {
#define PG8_LAS __attribute__((address_space(3)))
typedef unsigned short bf16_t;
typedef short bf16x8 __attribute__((ext_vector_type(8)));
typedef float f32x4 __attribute__((ext_vector_type(4)));
typedef unsigned u32x4 __attribute__((ext_vector_type(4)));
constexpr int BM = 256, BK = 64, HALF = 128, HTB = HALF * BK * 2  , STAGE_BYTES = 8 * HTB, NXCD = 8, WGM = 8;

__host__ __device__ __forceinline__ int lds_byte(int r, int c) { const int st = (r >> 4) * 2 + (c >> 5), rr = r & 15, cc = c & 31, ob = rr * 64 + cc * 2; return st * 1024 + (ob ^ (((ob >> 9) & 1) << 5)); }
__host__ __device__ __forceinline__ void stage_rc(int b, int& R, int& C) { const int st = b / 1024, sb = b % 1024, swz = sb ^ (((sb >> 9) & 1) << 5); R = (st >> 1) * 16 + swz / 64; C = (st & 1) * 32 + (swz % 64) / 2; }
__host__ __device__ __forceinline__ int perm32(int rho) { const int n = rho >> 4, i = rho & 15; return 8 * (i >> 2) + 4 * n + (i & 3); }

struct Unit { int pm, pn; };
struct Gemm { const bf16_t* A; const bf16_t* Bt; int M, N, K; };

struct StaticOrder {
    int nM, nN, nwg, G, c, rev;
    __host__ __device__ void init(int M, int N, int G_, int c_, int rev_ = 0) { nM = M / BM; nN = N / BM; nwg = nM * nN; G = G_; c = c_; rev = (rev_ && nwg % G_ == 0) ? 1 : 0; }
    __host__ __device__ bool next(int i, Unit& u) const {
        if (rev && i >= nwg / G) return false;
        const long L = (long)(rev ? nwg / G - 1 - i : i) * G + c; if (L >= nwg) return false;
        int wgid = (int)L; { const int q = nwg / NXCD, r = nwg % NXCD, xcd = wgid % NXCD, off = wgid / NXCD; wgid = (xcd < r ? xcd * (q + 1) : r * (q + 1) + (xcd - r) * q) + off; }
        const int nig = WGM * nN, gid = wgid / nig, fm = gid * WGM, gsz = (nM - fm) < WGM ? (nM - fm) : WGM;
        u.pm = fm + ((wgid % nig) % gsz); u.pn = (wgid % nig) / gsz; return true;
    }
    __device__ __forceinline__ void a_ready(const Unit&) const {}
    __device__ __forceinline__ void done(const Unit&) const {}
};

__device__ __forceinline__ unsigned cvt_pk_bf16(float lo, float hi) { unsigned r; asm volatile("v_cvt_pk_bf16_f32 %0, %1, %2" : "=v"(r) : "v"(lo), "v"(hi)); return r; }
typedef float f32x2 __attribute__((ext_vector_type(2)));
typedef unsigned u32x2 __attribute__((ext_vector_type(2)));
__device__ __forceinline__ float row_ss(const float* part, int row) { const f32x4* p = (const f32x4*)(part + (size_t)row * 16); const f32x4 a = (p[0] + p[1]) + (p[2] + p[3]); return (a[0] + a[1]) + (a[2] + a[3]); }
struct EpiProj {
    static constexpr bool PERM = true, AFTER_DRAIN = false;
    bf16_t* P; size_t sec_stride;
    const float* qg; const float* kg;
    const PG8_LAS float* rrt;
    __device__ __forceinline__ void operator()(const f32x4 (&acc)[2][2][4][2], const Unit& u, int wr, int wc, int fr, int fq) const {
        const int sec = u.pn >> 1;
        bf16_t* base = P + (size_t)sec * sec_stride;
        const int row0 = u.pm * BM + wr * 64 + fr;
        const int colb = (u.pn & 1) * 256 + wc * 64 + 8 * fq;
        float rr[2][4];
#pragma unroll
        for (int ai = 0; ai < 2; ++ai)
#pragma unroll
            for (int m = 0; m < 4; ++m) rr[ai][m] = rrt[(u.pm & 15) * 256 + wr * 64 + fr + ai * HALF + m * 16];
        if (sec <= 1) {
            const float* g = sec == 0 ? qg : kg;
            const float osc = sec == 0 ? 0.125f * 1.4426950408889634f : 1.0f;
            f32x4 gv[2][2];
#pragma unroll
            for (int bj = 0; bj < 2; ++bj)
#pragma unroll
                for (int n = 0; n < 2; ++n) gv[bj][n] = *(const f32x4*)(g + 32 * bj + 8 * fq + 4 * n) * osc;
#pragma unroll
            for (int ai = 0; ai < 2; ++ai)
#pragma unroll
                for (int m = 0; m < 4; ++m) {
                    float ss = 0.f;
#pragma unroll
                    for (int bj = 0; bj < 2; ++bj)
#pragma unroll
                        for (int n = 0; n < 2; ++n) { const f32x4 v = acc[ai][bj][m][n] * rr[ai][m]; ss += (v[0] * v[0] + v[1] * v[1]) + (v[2] * v[2] + v[3] * v[3]); }
                    ss += __shfl_xor(ss, 16); ss += __shfl_xor(ss, 32);
                    const float r = rr[ai][m] / sqrtf(ss * (1.0f / 64.0f) + 1e-6f);
                    bf16_t* rowp = base + (size_t)(row0 + ai * HALF + m * 16) * 512 + colb;
#pragma unroll
                    for (int bj = 0; bj < 2; ++bj) {
                        const f32x4 v0 = acc[ai][bj][m][0] * r * gv[bj][0], v1 = acc[ai][bj][m][1] * r * gv[bj][1];
                        u32x4 w; w.x = cvt_pk_bf16(v0[0], v0[1]); w.y = cvt_pk_bf16(v0[2], v0[3]); w.z = cvt_pk_bf16(v1[0], v1[1]); w.w = cvt_pk_bf16(v1[2], v1[3]);
                        *(u32x4*)(rowp + bj * 32) = w; }
                }
        } else {
            const float sc0 = sec == 4 ? 0.125f : 1.0f;
#pragma unroll
            for (int ai = 0; ai < 2; ++ai)
#pragma unroll
                for (int m = 0; m < 4; ++m) {
                    bf16_t* rowp = base + (size_t)(row0 + ai * HALF + m * 16) * 512 + colb; const float sc = sc0 * rr[ai][m];
#pragma unroll
                    for (int bj = 0; bj < 2; ++bj) {
                        const f32x4 v0 = acc[ai][bj][m][0] * sc, v1 = acc[ai][bj][m][1] * sc;
                        u32x4 w; w.x = cvt_pk_bf16(v0[0], v0[1]); w.y = cvt_pk_bf16(v0[2], v0[3]); w.z = cvt_pk_bf16(v1[0], v1[1]); w.w = cvt_pk_bf16(v1[2], v1[3]);
                        *(u32x4*)(rowp + bj * 32) = w; }
                }
        }
    }
};
__device__ __forceinline__ float bf_lo(unsigned w) { return __builtin_bit_cast(float, w << 16); }
__device__ __forceinline__ float bf_hi(unsigned w) { return __builtin_bit_cast(float, w & 0xffff0000u); }
struct EpiRes {
    static constexpr bool PERM = true, AFTER_DRAIN = false;
    bf16_t* xn; float* outf; int ldc; float* rowss;
    __device__ __forceinline__ void operator()(const f32x4 (&acc)[2][2][4][2], const Unit& u, int wr, int wc, int fr, int fq) const {
        const int col0 = u.pn * BM + wc * 32 + 8 * fq;
#pragma unroll
        for (int ai = 0; ai < 2; ++ai)
#pragma unroll
            for (int m = 0; m < 4; ++m) { const int row = u.pm * BM + ai * HALF + wr * 64 + m * 16 + fr; const size_t off = (size_t)row * ldc + col0; float ss = 0.f;
#pragma unroll
                for (int bj = 0; bj < 2; ++bj) { const u32x4 xb = *(const u32x4*)(xn + off + bj * HALF);
                    const f32x4 o0 = (f32x4){bf_lo(xb.x), bf_hi(xb.x), bf_lo(xb.y), bf_hi(xb.y)} + acc[ai][bj][m][0], o1 = (f32x4){bf_lo(xb.z), bf_hi(xb.z), bf_lo(xb.w), bf_hi(xb.w)} + acc[ai][bj][m][1];
                    if (outf) { *(f32x4*)(outf + off + bj * HALF) = o0; *(f32x4*)(outf + off + bj * HALF + 4) = o1; }
                    else { u32x4 w; w.x = cvt_pk_bf16(o0[0], o0[1]); w.y = cvt_pk_bf16(o0[2], o0[3]); w.z = cvt_pk_bf16(o1[0], o1[1]); w.w = cvt_pk_bf16(o1[2], o1[3]); *(u32x4*)(xn + off + bj * HALF) = w;
                        ss += ((o0[0] * o0[0] + o0[1] * o0[1]) + (o0[2] * o0[2] + o0[3] * o0[3])) + ((o1[0] * o1[0] + o1[1] * o1[1]) + (o1[2] * o1[2] + o1[3] * o1[3])); } }
                if (!outf) { ss += __shfl_xor(ss, 16); ss += __shfl_xor(ss, 32); if (fq == 0) rowss[(size_t)row * 16 + u.pn * 4 + wc] = ss; } }
    }
};
struct EpiRelu2 {
    static constexpr bool PERM = true, AFTER_DRAIN = false;
    bf16_t* O; int ldc; const PG8_LAS float* rrt;
    __device__ __forceinline__ void operator()(const f32x4 (&acc)[2][2][4][2], const Unit& u, int wr, int wc, int fr, int fq) const {
        const int row0 = u.pm * BM + wr * 64 + fr, col0 = u.pn * BM + wc * 32 + 8 * fq;
#pragma unroll
        for (int ai = 0; ai < 2; ++ai)
#pragma unroll
            for (int m = 0; m < 4; ++m) { bf16_t* rowp = O + (size_t)(row0 + ai * HALF + m * 16) * ldc + col0;
                const float rr = rrt[(u.pm & 15) * 256 + wr * 64 + fr + ai * HALF + m * 16];
#pragma unroll
                for (int bj = 0; bj < 2; ++bj) {
                    f32x4 v0 = acc[ai][bj][m][0], v1 = acc[ai][bj][m][1];
#pragma unroll
                    for (int e = 0; e < 4; ++e) { const float a = fmaxf(v0[e], 0.f) * rr, b = fmaxf(v1[e], 0.f) * rr; v0[e] = a * a; v1[e] = b * b; }
                    u32x4 w; w.x = cvt_pk_bf16(v0[0], v0[1]); w.y = cvt_pk_bf16(v0[2], v0[3]); w.z = cvt_pk_bf16(v1[0], v1[1]); w.w = cvt_pk_bf16(v1[2], v1[3]);
                    *(u32x4*)(rowp + bj * HALF) = w; } }
    }
};
template <class Epi, class Sched, bool ALIGN_EPI = false, bool SP2 = false>
__device__ __forceinline__ void gemm_phase(PG8_LAS unsigned char* lds, const Gemm g, const Sched& S, const Epi& E) {
    const int tid = fresh_tid(), wid = __builtin_amdgcn_readfirstlane(tid >> 6), lane = tid & 63, wr = wid >> 2, wc = wid & 3, fr = lane & 15, fq = lane >> 4;
    const int K = g.K, nt = K / BK;
    unsigned voffA[2], voffB[2];
#pragma unroll
    for (int i = 0; i < 2; ++i) { int R, C; stage_rc(tid * 16 + i * 8192, R, C); const int Rb = Epi::PERM ? ((R & ~31) + perm32(R & 31)) : R;
        voffA[i] = (unsigned)(R * K + C) * 2u; voffB[i] = (unsigned)(Rb * K + C) * 2u; }
    const size_t kstep = (size_t)(BK * 2);
    const size_t hstep = (size_t)HALF * K * 2;
    const size_t tstep = 2 * hstep;
    const unsigned ldsw = (unsigned)wid * 1024u;
    const int aoff = lds_byte(wr * 64 + fr, fq * 8), boff = lds_byte(wc * 32 + fr, fq * 8);
#define PG8_SA(b, h) (((b) * 2 + (h)) * HTB)
#define PG8_SB(b, h) ((4 + (b) * 2 + (h)) * HTB)
#define PG8_STAGE(bufoff, gbase, voff) do { _Pragma("unroll") for (int _i = 0; _i < 2; ++_i) \
        __builtin_amdgcn_global_load_lds((const unsigned*)((const char*)(gbase) + (voff)[_i]), (PG8_LAS unsigned*)(lds + (bufoff) + ldsw + _i * 8192), 16, 0, 0); } while (0)
#define PG8_LDA(dst, b, h) do { _Pragma("unroll") for (int m = 0; m < 4; ++m) _Pragma("unroll") for (int k = 0; k < 2; ++k) dst[m][k] = *(const PG8_LAS bf16x8*)(lds + PG8_SA(b, h) + aoff + m * 2048 + k * 1024); } while (0)
#define PG8_LDB(dst, b, h) do { _Pragma("unroll") for (int n = 0; n < 2; ++n) _Pragma("unroll") for (int k = 0; k < 2; ++k) dst[n][k] = *(const PG8_LAS bf16x8*)(lds + PG8_SB(b, h) + boff + n * 2048 + k * 1024); } while (0)
#define PG8_MMA(ai, bj, At, Bt) do { __builtin_amdgcn_s_setprio(1); _Pragma("unroll") for (int m = 0; m < 4; ++m) _Pragma("unroll") for (int n = 0; n < 2; ++n) _Pragma("unroll") for (int k = 0; k < 2; ++k) \
        acc[ai][bj][m][n] = __builtin_amdgcn_mfma_f32_16x16x32_bf16(Bt[n][k], At[m][k], acc[ai][bj][m][n], 0, 0, 0); __builtin_amdgcn_s_setprio(0); } while (0)
#define PG8_WAIT_V(n) asm volatile("s_waitcnt vmcnt(" #n ")" ::: "memory")
#define PG8_WAIT_L(n) asm volatile("s_waitcnt lgkmcnt(" #n ")" ::: "memory")
#define PG8_BAR __builtin_amdgcn_s_barrier()
#define PG8_SCHED __builtin_amdgcn_sched_barrier(0)
    Unit cur, nxt; int ui = 0;
    if (!S.next(0, cur)) return;
    f32x4 acc[2][2][4][2];
#pragma unroll
    for (int a = 0; a < 2; ++a)
#pragma unroll
        for (int b = 0; b < 2; ++b)
#pragma unroll
            for (int m = 0; m < 4; ++m)
#pragma unroll
                for (int n = 0; n < 2; ++n) acc[a][b][m][n] = (f32x4){0.f, 0.f, 0.f, 0.f};
    bf16x8 At[4][2], B0[2][2], B1[2][2];
    const char* cA = (const char*)g.A + (size_t)cur.pm * tstep; const char* cB = (const char*)g.Bt + (size_t)cur.pn * tstep;
    S.a_ready(cur);
    if constexpr (SP2) {
        PG8_STAGE(PG8_SB(0, 0), cB, voffB); PG8_STAGE(PG8_SB(0, 1), cB + hstep, voffB); PG8_STAGE(PG8_SA(0, 0), cA, voffA); PG8_STAGE(PG8_SA(0, 1), cA + hstep, voffA);
        if (wr == 1) PG8_BAR;
        PG8_WAIT_V(2); PG8_BAR;
        PG8_STAGE(PG8_SB(1, 0), cB + kstep, voffB); PG8_STAGE(PG8_SA(1, 0), cA + kstep, voffA); PG8_STAGE(PG8_SB(1, 1), cB + hstep + kstep, voffB);
        PG8_WAIT_V(6); PG8_BAR;
    } else {
        PG8_STAGE(PG8_SB(0, 0), cB, voffB); PG8_STAGE(PG8_SA(0, 0), cA, voffA); PG8_STAGE(PG8_SB(0, 1), cB + hstep, voffB); PG8_STAGE(PG8_SA(0, 1), cA + hstep, voffA);
        if (wr == 1) PG8_BAR;
        PG8_WAIT_V(4); PG8_BAR;
        PG8_STAGE(PG8_SB(1, 0), cB + kstep, voffB); PG8_STAGE(PG8_SA(1, 0), cA + kstep, voffA); PG8_STAGE(PG8_SB(1, 1), cB + hstep + kstep, voffB);
        PG8_WAIT_V(6); PG8_BAR;
    }
    for (;;) {
        const bool has_next = S.next(ui + 1, nxt);
        const char* nA = has_next ? (const char*)g.A + (size_t)nxt.pm * tstep : cA; const char* nB = has_next ? (const char*)g.Bt + (size_t)nxt.pn * tstep : cB;
        for (int t = 0; t < nt; t += 2) {
            const bool last = (t == nt - 2);
            const char* a1 = cA + (size_t)(t + 1) * kstep;
            const char* a2 = last ? nA : cA + (size_t)(t + 2) * kstep; const char* b2 = last ? nB : cB + (size_t)(t + 2) * kstep;
            const char* a3 = a2 + kstep; const char* b3 = b2 + kstep;
            if (last && has_next) S.a_ready(nxt);
            if constexpr (SP2) {
            PG8_LDB(B0, 0, 0); PG8_LDB(B1, 0, 1); PG8_SCHED; PG8_LDA(At, 0, 0); PG8_STAGE(PG8_SA(1, 1), a1 + hstep, voffA);
            PG8_WAIT_V(8); PG8_WAIT_L(0); PG8_BAR; PG8_MMA(0, 0, At, B0); PG8_MMA(0, 1, At, B1); PG8_BAR; PG8_SCHED;
            PG8_LDA(At, 0, 1); PG8_STAGE(PG8_SB(0, 0), b2, voffB); PG8_STAGE(PG8_SB(0, 1), b2 + hstep, voffB); PG8_STAGE(PG8_SA(0, 0), a2, voffA);
            PG8_WAIT_V(8); PG8_WAIT_L(0); PG8_BAR; PG8_MMA(1, 0, At, B0); PG8_MMA(1, 1, At, B1); PG8_BAR; PG8_SCHED;
            PG8_LDB(B0, 1, 0); PG8_LDB(B1, 1, 1); PG8_SCHED; PG8_LDA(At, 1, 0); PG8_STAGE(PG8_SA(0, 1), a2 + hstep, voffA);
            PG8_WAIT_V(8); PG8_WAIT_L(0); PG8_BAR; PG8_MMA(0, 0, At, B0); PG8_MMA(0, 1, At, B1); PG8_BAR; PG8_SCHED;
            PG8_LDA(At, 1, 1); PG8_STAGE(PG8_SB(1, 0), b3, voffB); PG8_STAGE(PG8_SB(1, 1), b3 + hstep, voffB); PG8_STAGE(PG8_SA(1, 0), a3, voffA);
            PG8_WAIT_V(8); PG8_WAIT_L(0); PG8_BAR; PG8_MMA(1, 0, At, B0); PG8_MMA(1, 1, At, B1); PG8_BAR; PG8_SCHED;
            } else {
            PG8_LDB(B0, 0, 0); PG8_SCHED; PG8_LDA(At, 0, 0); PG8_STAGE(PG8_SA(1, 1), a1 + hstep, voffA);
            PG8_WAIT_L(8); PG8_BAR; PG8_WAIT_L(0); PG8_MMA(0, 0, At, B0); PG8_BAR; PG8_SCHED;
            PG8_LDB(B1, 0, 1); PG8_STAGE(PG8_SB(0, 0), b2, voffB);
            PG8_BAR; PG8_WAIT_L(0); PG8_MMA(0, 1, At, B1); PG8_BAR;
            PG8_LDA(At, 0, 1); PG8_STAGE(PG8_SA(0, 0), a2, voffA);
            PG8_BAR; PG8_WAIT_L(0); PG8_MMA(1, 0, At, B0); PG8_BAR; PG8_SCHED;
            PG8_STAGE(PG8_SB(0, 1), b2 + hstep, voffB);
            PG8_WAIT_V(6); PG8_BAR; PG8_MMA(1, 1, At, B1); PG8_BAR;
            PG8_LDB(B0, 1, 0); PG8_SCHED; PG8_LDA(At, 1, 0); PG8_STAGE(PG8_SA(0, 1), a2 + hstep, voffA);
            PG8_WAIT_L(8); PG8_BAR; PG8_WAIT_L(0); PG8_MMA(0, 0, At, B0); PG8_BAR; PG8_SCHED;
            PG8_LDB(B1, 1, 1); PG8_STAGE(PG8_SB(1, 0), b3, voffB);
            PG8_BAR; PG8_WAIT_L(0); PG8_MMA(0, 1, At, B1); PG8_BAR;
            PG8_LDA(At, 1, 1); PG8_STAGE(PG8_SA(1, 0), a3, voffA);
            PG8_BAR; PG8_WAIT_L(0); PG8_MMA(1, 0, At, B0); PG8_BAR; PG8_SCHED;
            PG8_STAGE(PG8_SB(1, 1), b3 + hstep, voffB);
            PG8_WAIT_V(6); PG8_BAR; PG8_MMA(1, 1, At, B1); PG8_BAR;
            }
        }
        if constexpr (ALIGN_EPI) { if (wr == 0) PG8_BAR; }
        if constexpr (!Epi::AFTER_DRAIN) { E(acc, cur, wr, wc, fr, fq); S.done(cur); }
        if (!has_next) break;
#pragma unroll
        for (int a = 0; a < 2; ++a)
#pragma unroll
            for (int b = 0; b < 2; ++b)
#pragma unroll
                for (int m = 0; m < 4; ++m)
#pragma unroll
                    for (int n = 0; n < 2; ++n) acc[a][b][m][n] = (f32x4){0.f, 0.f, 0.f, 0.f};
        cur = nxt; cA = nA; cB = nB; ++ui;
        if constexpr (ALIGN_EPI) { if (wr == 1) PG8_BAR; }
    }
    PG8_WAIT_V(0);
    if constexpr (!ALIGN_EPI) { if (wr == 0) PG8_BAR; }
    PG8_BAR;
    if constexpr (Epi::AFTER_DRAIN) { E.fused(acc, cur, wr, wc, fr, fq, lds, wid, lane); S.done(cur); }
#undef PG8_SA
#undef PG8_SB
#undef PG8_STAGE
#undef PG8_LDA
#undef PG8_LDB
#undef PG8_MMA
#undef PG8_WAIT_V
#undef PG8_WAIT_L
#undef PG8_BAR
#undef PG8_SCHED
}
}
#define LAS __attribute__((address_space(3)))
using pg8::bf16_t; using pg8::bf16x8; using pg8::f32x4; using pg8::u32x4;
typedef short s16x4 __attribute__((ext_vector_type(4)));
typedef float f32x16 __attribute__((ext_vector_type(16)));
using pg8::u32x2;
typedef unsigned char uchar;

constexpr int BATCH = 8, SEQ = 4096, DM = 1024, DEPTH = 4, M = BATCH * SEQ, NIN = 3584, FF = 4096;
constexpr float EPS = 1e-6f, LOG2E = 1.4426950408889634f;
constexpr size_t MiB = 1u << 20;
constexpr size_t WS_W = 2 * MiB, W_LAYER = 25 * MiB, W_IN = 0, W_OUT = 7 * MiB, W_1 = 9 * MiB, W_2 = 17 * MiB;
constexpr size_t WS_XN = 104 * MiB;
constexpr size_t WS_MIX = 168 * MiB;
constexpr size_t WS_PROJ = 232 * MiB;
constexpr size_t SEC = 32 * MiB;
constexpr size_t WS_ST = 456 * MiB;
constexpr size_t WS_END = 504 * MiB;
constexpr int LDS_BYTES = 148480, MISC_OFF = 147456;
constexpr size_t WS_CTL = 0, WS_ROWSS = 488 * MiB, CTL_BYTES = 65536;
constexpr int NWAVES = 8;

__device__ __forceinline__ unsigned f2bf(float f) { unsigned u = __builtin_bit_cast(unsigned, f); return (u + 0x7fffu + ((u >> 16) & 1u)) >> 16; }
__device__ __forceinline__ unsigned pk2(float lo, float hi) { return pg8::cvt_pk_bf16(lo, hi); }
__device__ __forceinline__ float bflo(unsigned w) { return __builtin_bit_cast(float, w << 16); }
__device__ __forceinline__ float bfhi(unsigned w) { return __builtin_bit_cast(float, w & 0xffff0000u); }
__device__ __forceinline__ float wave_sum(float v) {
#pragma unroll
    for (int o = 1; o < 64; o <<= 1) v += __shfl_xor(v, o);
    return v;
}
__device__ __forceinline__ s16x4 tr16(const LAS uchar* p) { return __builtin_bit_cast(s16x4, __builtin_amdgcn_ds_read_tr16_b64_v4i16((LAS s16x4*)p)); }
__device__ __forceinline__ bf16x8 cat8(s16x4 lo, s16x4 hi) { return (bf16x8){lo[0], lo[1], lo[2], lo[3], hi[0], hi[1], hi[2], hi[3]}; }
#define LDS_WAIT() asm volatile("s_waitcnt lgkmcnt(0)" ::: "memory")

__device__ __forceinline__ void transpose_item(const float* W, int K, int N, bf16_t* WT, const float* gain, bool perm, LAS float* scr, int item, int lane) {
    const int nblk = N / 32, kb = item / nblk, nb = item % nblk, k0 = 64 * kb, n0 = 32 * nb;
    float wv[32];
#pragma unroll
    for (int i = 0; i < 32; ++i) { const int kk = 2 * i + (lane >> 5); wv[i] = __builtin_nontemporal_load(W + (size_t)(k0 + kk) * N + n0 + (lane & 31)); }
    if (gain) {
#pragma unroll
        for (int i = 0; i < 32; ++i) wv[i] *= gain[k0 + 2 * i + (lane >> 5)];
    }
#pragma unroll
    for (int i = 0; i < 32; ++i) { const int kk = 2 * i + (lane >> 5); scr[kk * 33 + (lane & 31)] = wv[i]; }
    LDS_WAIT(); asm volatile("" ::: "memory");
    int nrow0 = n0;
    if (perm) { const int o = nb & 7, wc = o >> 1, bj = o & 1; nrow0 = (nb & ~7) * 32 + (4 * bj + wc) * 32; }
    const int c = lane & 7;
#pragma unroll
    for (int j = 0; j < 4; ++j) { const int n = (lane >> 3) + 8 * j; const LAS float* s = scr + (8 * c) * 33 + n;
        u32x4 o; o.x = pk2(s[0 * 33], s[1 * 33]); o.y = pk2(s[2 * 33], s[3 * 33]); o.z = pk2(s[4 * 33], s[5 * 33]); o.w = pk2(s[6 * 33], s[7 * 33]);
        *(u32x4*)(WT + (size_t)(nrow0 + n) * K + k0 + 8 * c) = o; }
    LDS_WAIT(); asm volatile("" ::: "memory");
}
__device__ __forceinline__ void norm_rows(const float* x, bf16_t* xn, float* rowss, int gw, int ngw, int lane) {
    for (int m = gw; m < M; m += ngw) {
        const f32x4* xr = (const f32x4*)(x + (size_t)m * DM) + lane;
        f32x4 v[4]; float s = 0.f;
#pragma unroll
        for (int j = 0; j < 4; ++j) { v[j] = __builtin_nontemporal_load(xr + 64 * j); s += (v[j][0] * v[j][0] + v[j][1] * v[j][1]) + (v[j][2] * v[j][2] + v[j][3] * v[j][3]); }
        s = wave_sum(s);
        if (lane < 16) rowss[(size_t)m * 16 + lane] = lane == 0 ? s : 0.f;
        u32x2* o8 = (u32x2*)(xn + (size_t)m * DM) + lane;
#pragma unroll
        for (int j = 0; j < 4; ++j) { u32x2 w; w.x = pk2(v[j][0], v[j][1]); w.y = pk2(v[j][2], v[j][3]); o8[64 * j] = w; }
    }
}

constexpr int RRT_OFF = 131072;
__device__ __forceinline__ void fill_rrt(LAS uchar* lds, const float* part, int pm_base) {
    const int tid = fresh_tid();
    LAS float* rrt = (LAS float*)(lds + RRT_OFF);
#pragma unroll
    for (int i = 0; i < 8; ++i) { const int r = tid + i * 512; rrt[r] = 1.0f / sqrtf(pg8::row_ss(part, pm_base * 256 + r) * (1.0f / 1024.0f) + EPS); }
    __syncthreads();
}

constexpr int AKP = 272, AVP = 320, AKT = 64 * AKP, AVT = 64 * AVP, AVOFF = 2 * AKT;
static_assert(AVOFF + 3 * AVT <= 131072 && 65536 <= AVOFF + 3 * AVT, "attention LDS");
__device__ __forceinline__ void attn_unit(LAS uchar* lds, int b, int h, int qb, const bf16_t* DQ, const bf16_t* DK, const bf16_t* DV, bf16_t* MIX,
                                          float lam, float slope2, float B2, const float* og, float oscale, int tlo, int cnt) {
    const int tid = fresh_tid(), lane = tid & 63, wid = __builtin_amdgcn_readfirstlane(tid >> 6), comp = wid >> 2, qg = wid & 3, r32 = lane & 31, hh = lane >> 5;
    const size_t tok0 = (size_t)b * SEQ;
    const int qpos = qb * 128 + qg * 32 + r32;
    bf16x8 qf[4];
    { const bf16_t* qp = DQ + (tok0 + qpos) * 512 + h * 128 + comp * 64 + hh * 8;
#pragma unroll
      for (int kk = 0; kk < 4; ++kk) qf[kk] = *(const bf16x8*)(qp + 16 * kk); }
    const int srow = tid >> 4, sch = tid & 15;
    const bf16_t* kg = DK + (tok0 + srow) * 512 + h * 128 + sch * 8;
    const bf16_t* vg = DV + (tok0 + srow) * 512 + h * 128 + sch * 8;
    u32x4 kr0, kr1, vr0, vr1;
    const int t0 = qb * 2;
    unsigned kxo, kxj0, kxj1;
    { const unsigned j0 = f2bf((float)r32), j1 = f2bf((float)(r32 + 32)); kxo = hh ? 0u : 0x3f803f80u; kxj0 = hh ? 0u : (j0 | (j0 << 16)); kxj1 = hh ? 0u : (j1 | (j1 << 16)); }
    const int Q0 = qb * 128 + qg * 32;
#define A_GLOAD(t) do { const size_t o_ = (size_t)(t) * 64 * 512; kr0 = *(const u32x4*)(kg + o_); kr1 = *(const u32x4*)(kg + o_ + 32 * 512); vr0 = *(const u32x4*)(vg + o_); vr1 = *(const u32x4*)(vg + o_ + 32 * 512); } while (0)
#define SB_() __builtin_amdgcn_sched_barrier(0)
#define A_VLD(dst, c_) do { _Pragma("unroll") for (int k_ = 0; k_ < 4; ++k_) { dst[k_][0] = tr16(vp_ + (16 * (c_)) * AVP + k_ * 64); dst[k_][1] = tr16(vp_ + (16 * (c_) + 8) * AVP + k_ * 64); } } while (0)
#define A_VMM(src, c_) do { _Pragma("unroll") for (int k_ = 0; k_ < 4; ++k_) o[k_] = __builtin_amdgcn_mfma_f32_32x32x16_bf16(cat8(src[k_][0], src[k_][1]), pf[c_], o[k_], 0, 0, 0); } while (0)
#define A_PV(vbuf) do { const LAS uchar* vp_ = (vbuf) + (4 * hh + ((lane & 15) >> 2)) * AVP + ((lane >> 4) & 1) * 32 + (lane & 3) * 8; \
        s16x4 va_[4][2], vb_[4][2]; \
        SB_(); A_VLD(va_, 0); A_VLD(vb_, 1); SB_(); A_VMM(va_, 0); SB_(); A_VLD(va_, 2); SB_(); A_VMM(vb_, 1); SB_(); A_VLD(vb_, 3); SB_(); A_VMM(va_, 2); SB_(); A_VMM(vb_, 3); SB_(); } while (0)
    f32x16 o[4];
#pragma unroll
    for (int k = 0; k < 4; ++k)
#pragma unroll
        for (int i = 0; i < 16; ++i) o[k][i] = 0.f;
    bf16x8 pf[4];
#pragma unroll
    for (int k = 0; k < 4; ++k) pf[k] = (bf16x8){0, 0, 0, 0, 0, 0, 0, 0};
    float lsum = 0.f;
    A_GLOAD(t0);
    int trel = t0 - tlo, vcur = 0, vprev = 2;
    const LAS uchar* vfr = lds + AVOFF + (4 * hh + ((lane & 15) >> 2)) * AVP + ((lane >> 4) & 1) * 32 + (lane & 3) * 8;
    for (int it = 0; it < cnt; ++it) {
        const int t = tlo + trel;
        trel = (trel + 1 == cnt) ? 0 : trel + 1;
        LAS uchar* kb = lds + (it & 1) * AKT; LAS uchar* vb = lds + AVOFF + vcur * AVT;
        *(LAS u32x4*)(kb + srow * AKP + sch * 16) = kr0; *(LAS u32x4*)(kb + (srow + 32) * AKP + sch * 16) = kr1;
        *(LAS u32x4*)(vb + srow * AVP + sch * 16) = vr0; *(LAS u32x4*)(vb + (srow + 32) * AVP + sch * 16) = vr1;
        __syncthreads();
        if (it + 1 < cnt) { const int tn = tlo + trel; A_GLOAD(tn); }
        const LAS uchar* vp_ = vfr + vprev * AVT;
        s16x4 va_[4][2], vb_[4][2];
        if (it > 0) { A_VLD(va_, 0); }
        const bool general = it < 2;
        bf16x8 qx;
        { const float sg = (t > t0) ? 1.0f : -1.0f;
          const float av = general ? -B2 : sg * slope2 * (float)(r32 - (64 * t - Q0)) - B2, bv = general ? 0.f : -sg * slope2;
          const unsigned t1 = pk2(av, bv), t2 = pk2(av - bflo(t1), bv - bfhi(t1));
          u32x4 w; w.x = hh ? 0u : ((t1 & 0xffffu) | (t2 << 16)); w.y = hh ? 0u : ((t1 >> 16) | (t2 & 0xffff0000u)); w.z = 0u; w.w = 0u; qx = __builtin_bit_cast(bf16x8, w); }
        f32x16 s0, s1;
#pragma unroll
        for (int i = 0; i < 16; ++i) { s0[i] = 0.f; s1[i] = 0.f; }
        { const LAS uchar* kp = kb + r32 * AKP + comp * 128 + hh * 16;
          bf16x8 a0[4], a1[4];
#pragma unroll
          for (int kk = 0; kk < 4; ++kk) { a0[kk] = *(const LAS bf16x8*)(kp + kk * 32); a1[kk] = *(const LAS bf16x8*)(kp + 32 * AKP + kk * 32); }
          SB_();
          { unsigned ko_ = kxo, ka_ = kxj0, kb_ = kxj1; asm volatile("" : "+v"(ko_), "+v"(ka_), "+v"(kb_));
            s0 = __builtin_amdgcn_mfma_f32_32x32x16_bf16(__builtin_bit_cast(bf16x8, (u32x4){ko_, ka_, 0u, 0u}), qx, s0, 0, 0, 0);
            s1 = __builtin_amdgcn_mfma_f32_32x32x16_bf16(__builtin_bit_cast(bf16x8, (u32x4){ko_, kb_, 0u, 0u}), qx, s1, 0, 0, 0); }
#pragma unroll
          for (int kk = 0; kk < 4; ++kk) {
              s0 = __builtin_amdgcn_mfma_f32_32x32x16_bf16(a0[kk], qf[kk], s0, 0, 0, 0);
              s1 = __builtin_amdgcn_mfma_f32_32x32x16_bf16(a1[kk], qf[kk], s1, 0, 0, 0); } }
        if (general) {
            const float qk = (float)(qpos - t * 64 - 4 * hh);
#pragma unroll
            for (int i = 0; i < 16; ++i) { const float c = (float)(8 * (i >> 2) + (i & 3));
                s0[i] = __builtin_fmaf(-slope2, __builtin_fabsf(qk - c), s0[i]); s1[i] = __builtin_fmaf(-slope2, __builtin_fabsf(qk - (c + 32.f)), s1[i]); }
        }
        float ps = 0.f;
        u32x4 w0, w1, w2, w3;
        if (it > 0) {
            SB_();
            o[0] = __builtin_amdgcn_mfma_f32_32x32x16_bf16(cat8(va_[0][0], va_[0][1]), pf[0], o[0], 0, 0, 0); vb_[0][0] = tr16(vp_ + (16 * 1) * AVP + 0 * 64); vb_[0][1] = tr16(vp_ + (16 * 1 + 8) * AVP + 0 * 64); s0[0] = __builtin_amdgcn_exp2f(s0[0]); s1[0] = __builtin_amdgcn_exp2f(s1[0]); ps += s0[0] + s1[0]; SB_();
            o[1] = __builtin_amdgcn_mfma_f32_32x32x16_bf16(cat8(va_[1][0], va_[1][1]), pf[0], o[1], 0, 0, 0); vb_[1][0] = tr16(vp_ + (16 * 1) * AVP + 1 * 64); vb_[1][1] = tr16(vp_ + (16 * 1 + 8) * AVP + 1 * 64); s0[1] = __builtin_amdgcn_exp2f(s0[1]); s1[1] = __builtin_amdgcn_exp2f(s1[1]); ps += s0[1] + s1[1]; w0.x = pk2(s0[0], s0[1]); w2.x = pk2(s1[0], s1[1]); SB_();
            o[2] = __builtin_amdgcn_mfma_f32_32x32x16_bf16(cat8(va_[2][0], va_[2][1]), pf[0], o[2], 0, 0, 0); vb_[2][0] = tr16(vp_ + (16 * 1) * AVP + 2 * 64); vb_[2][1] = tr16(vp_ + (16 * 1 + 8) * AVP + 2 * 64); s0[2] = __builtin_amdgcn_exp2f(s0[2]); s1[2] = __builtin_amdgcn_exp2f(s1[2]); ps += s0[2] + s1[2]; SB_();
            o[3] = __builtin_amdgcn_mfma_f32_32x32x16_bf16(cat8(va_[3][0], va_[3][1]), pf[0], o[3], 0, 0, 0); vb_[3][0] = tr16(vp_ + (16 * 1) * AVP + 3 * 64); vb_[3][1] = tr16(vp_ + (16 * 1 + 8) * AVP + 3 * 64); s0[3] = __builtin_amdgcn_exp2f(s0[3]); s1[3] = __builtin_amdgcn_exp2f(s1[3]); ps += s0[3] + s1[3]; w0.y = pk2(s0[2], s0[3]); w2.y = pk2(s1[2], s1[3]); SB_();
            o[0] = __builtin_amdgcn_mfma_f32_32x32x16_bf16(cat8(vb_[0][0], vb_[0][1]), pf[1], o[0], 0, 0, 0); va_[0][0] = tr16(vp_ + (16 * 2) * AVP + 0 * 64); va_[0][1] = tr16(vp_ + (16 * 2 + 8) * AVP + 0 * 64); s0[4] = __builtin_amdgcn_exp2f(s0[4]); s1[4] = __builtin_amdgcn_exp2f(s1[4]); ps += s0[4] + s1[4]; SB_();
            o[1] = __builtin_amdgcn_mfma_f32_32x32x16_bf16(cat8(vb_[1][0], vb_[1][1]), pf[1], o[1], 0, 0, 0); va_[1][0] = tr16(vp_ + (16 * 2) * AVP + 1 * 64); va_[1][1] = tr16(vp_ + (16 * 2 + 8) * AVP + 1 * 64); s0[5] = __builtin_amdgcn_exp2f(s0[5]); s1[5] = __builtin_amdgcn_exp2f(s1[5]); ps += s0[5] + s1[5]; w0.z = pk2(s0[4], s0[5]); w2.z = pk2(s1[4], s1[5]); SB_();
            o[2] = __builtin_amdgcn_mfma_f32_32x32x16_bf16(cat8(vb_[2][0], vb_[2][1]), pf[1], o[2], 0, 0, 0); va_[2][0] = tr16(vp_ + (16 * 2) * AVP + 2 * 64); va_[2][1] = tr16(vp_ + (16 * 2 + 8) * AVP + 2 * 64); s0[6] = __builtin_amdgcn_exp2f(s0[6]); s1[6] = __builtin_amdgcn_exp2f(s1[6]); ps += s0[6] + s1[6]; SB_();
            o[3] = __builtin_amdgcn_mfma_f32_32x32x16_bf16(cat8(vb_[3][0], vb_[3][1]), pf[1], o[3], 0, 0, 0); va_[3][0] = tr16(vp_ + (16 * 2) * AVP + 3 * 64); va_[3][1] = tr16(vp_ + (16 * 2 + 8) * AVP + 3 * 64); s0[7] = __builtin_amdgcn_exp2f(s0[7]); s1[7] = __builtin_amdgcn_exp2f(s1[7]); ps += s0[7] + s1[7]; w0.w = pk2(s0[6], s0[7]); w2.w = pk2(s1[6], s1[7]); SB_();
            o[0] = __builtin_amdgcn_mfma_f32_32x32x16_bf16(cat8(va_[0][0], va_[0][1]), pf[2], o[0], 0, 0, 0); vb_[0][0] = tr16(vp_ + (16 * 3) * AVP + 0 * 64); vb_[0][1] = tr16(vp_ + (16 * 3 + 8) * AVP + 0 * 64); s0[8] = __builtin_amdgcn_exp2f(s0[8]); s1[8] = __builtin_amdgcn_exp2f(s1[8]); ps += s0[8] + s1[8]; SB_();
            o[1] = __builtin_amdgcn_mfma_f32_32x32x16_bf16(cat8(va_[1][0], va_[1][1]), pf[2], o[1], 0, 0, 0); vb_[1][0] = tr16(vp_ + (16 * 3) * AVP + 1 * 64); vb_[1][1] = tr16(vp_ + (16 * 3 + 8) * AVP + 1 * 64); s0[9] = __builtin_amdgcn_exp2f(s0[9]); s1[9] = __builtin_amdgcn_exp2f(s1[9]); ps += s0[9] + s1[9]; w1.x = pk2(s0[8], s0[9]); w3.x = pk2(s1[8], s1[9]); SB_();
            o[2] = __builtin_amdgcn_mfma_f32_32x32x16_bf16(cat8(va_[2][0], va_[2][1]), pf[2], o[2], 0, 0, 0); vb_[2][0] = tr16(vp_ + (16 * 3) * AVP + 2 * 64); vb_[2][1] = tr16(vp_ + (16 * 3 + 8) * AVP + 2 * 64); s0[10] = __builtin_amdgcn_exp2f(s0[10]); s1[10] = __builtin_amdgcn_exp2f(s1[10]); ps += s0[10] + s1[10]; SB_();
            o[3] = __builtin_amdgcn_mfma_f32_32x32x16_bf16(cat8(va_[3][0], va_[3][1]), pf[2], o[3], 0, 0, 0); vb_[3][0] = tr16(vp_ + (16 * 3) * AVP + 3 * 64); vb_[3][1] = tr16(vp_ + (16 * 3 + 8) * AVP + 3 * 64); s0[11] = __builtin_amdgcn_exp2f(s0[11]); s1[11] = __builtin_amdgcn_exp2f(s1[11]); ps += s0[11] + s1[11]; w1.y = pk2(s0[10], s0[11]); w3.y = pk2(s1[10], s1[11]); SB_();
            o[0] = __builtin_amdgcn_mfma_f32_32x32x16_bf16(cat8(vb_[0][0], vb_[0][1]), pf[3], o[0], 0, 0, 0); s0[12] = __builtin_amdgcn_exp2f(s0[12]); s1[12] = __builtin_amdgcn_exp2f(s1[12]); ps += s0[12] + s1[12]; SB_();
            o[1] = __builtin_amdgcn_mfma_f32_32x32x16_bf16(cat8(vb_[1][0], vb_[1][1]), pf[3], o[1], 0, 0, 0); s0[13] = __builtin_amdgcn_exp2f(s0[13]); s1[13] = __builtin_amdgcn_exp2f(s1[13]); ps += s0[13] + s1[13]; w1.z = pk2(s0[12], s0[13]); w3.z = pk2(s1[12], s1[13]); SB_();
            o[2] = __builtin_amdgcn_mfma_f32_32x32x16_bf16(cat8(vb_[2][0], vb_[2][1]), pf[3], o[2], 0, 0, 0); s0[14] = __builtin_amdgcn_exp2f(s0[14]); s1[14] = __builtin_amdgcn_exp2f(s1[14]); ps += s0[14] + s1[14]; SB_();
            o[3] = __builtin_amdgcn_mfma_f32_32x32x16_bf16(cat8(vb_[3][0], vb_[3][1]), pf[3], o[3], 0, 0, 0); s0[15] = __builtin_amdgcn_exp2f(s0[15]); s1[15] = __builtin_amdgcn_exp2f(s1[15]); ps += s0[15] + s1[15]; w1.w = pk2(s0[14], s0[15]); w3.w = pk2(s1[14], s1[15]); SB_();
        } else {
#pragma unroll
            for (int i = 0; i < 16; ++i) { s0[i] = __builtin_amdgcn_exp2f(s0[i]); s1[i] = __builtin_amdgcn_exp2f(s1[i]); ps += s0[i] + s1[i]; }
            w0.x = pk2(s0[0], s0[1]); w0.y = pk2(s0[2], s0[3]); w0.z = pk2(s0[4], s0[5]); w0.w = pk2(s0[6], s0[7]);
            w1.x = pk2(s0[8], s0[9]); w1.y = pk2(s0[10], s0[11]); w1.z = pk2(s0[12], s0[13]); w1.w = pk2(s0[14], s0[15]);
            w2.x = pk2(s1[0], s1[1]); w2.y = pk2(s1[2], s1[3]); w2.z = pk2(s1[4], s1[5]); w2.w = pk2(s1[6], s1[7]);
            w3.x = pk2(s1[8], s1[9]); w3.y = pk2(s1[10], s1[11]); w3.z = pk2(s1[12], s1[13]); w3.w = pk2(s1[14], s1[15]);
        }
        lsum += ps;
        pf[0] = __builtin_bit_cast(bf16x8, w0); pf[1] = __builtin_bit_cast(bf16x8, w1); pf[2] = __builtin_bit_cast(bf16x8, w2); pf[3] = __builtin_bit_cast(bf16x8, w3);
        vprev = vcur; vcur = (vcur == 2) ? 0 : vcur + 1;
    }
    A_PV(lds + AVOFF + vprev * AVT);
#undef A_GLOAD
#undef A_PV
#undef A_VLD
#undef A_VMM
#undef SB_
    { const auto rr_ = __builtin_amdgcn_permlane32_swap(__float_as_uint(lsum), __float_as_uint(lsum), false, false); lsum = __uint_as_float(rr_[0]) + __uint_as_float(rr_[1]); }
    const float inv = 1.0f / lsum;
    LAS f32x4* X = (LAS f32x4*)lds + qg * 1024 + lane;
    __syncthreads();
    if (comp == 1) {
#pragma unroll
        for (int k = 0; k < 4; ++k)
#pragma unroll
            for (int i4 = 0; i4 < 4; ++i4) X[(k * 4 + i4) * 64] = (f32x4){o[k][4 * i4] * inv, o[k][4 * i4 + 1] * inv, o[k][4 * i4 + 2] * inv, o[k][4 * i4 + 3] * inv};
    }
    __syncthreads();
    if (comp == 0) {
        float ss = 0.f;
#pragma unroll
        for (int k = 0; k < 4; ++k)
#pragma unroll
            for (int i4 = 0; i4 < 4; ++i4) { const f32x4 x4 = X[(k * 4 + i4) * 64];
#pragma unroll
                for (int e = 0; e < 4; ++e) { const float a = o[k][4 * i4 + e] * inv - lam * x4[e]; o[k][4 * i4 + e] = a; ss += a * a; } }
        { const auto rr_ = __builtin_amdgcn_permlane32_swap(__float_as_uint(ss), __float_as_uint(ss), false, false); ss = __uint_as_float(rr_[0]) + __uint_as_float(rr_[1]); }
        const float r = oscale / sqrtf(ss * (1.0f / 128.0f) + EPS);
        bf16_t* mp = MIX + (tok0 + qpos) * 1024 + h * 128 + 4 * hh;
#pragma unroll
        for (int k = 0; k < 4; ++k)
#pragma unroll
            for (int q4 = 0; q4 < 4; ++q4) {
                const int dv = 32 * k + 8 * q4; const f32x4 g = *(const f32x4*)(og + dv + 4 * hh);
                u32x2 w; w.x = pk2(o[k][4 * q4] * r * g[0], o[k][4 * q4 + 1] * r * g[1]); w.y = pk2(o[k][4 * q4 + 2] * r * g[2], o[k][4 * q4 + 3] * r * g[3]);
                *(u32x2*)(mp + dv) = w; }
    }
    __syncthreads();
}

constexpr int RPR = 144, RPV = 160;
__device__ __forceinline__ bf16x8 trpair(const LAS uchar* p) { return cat8(tr16(p), tr16(p + 16 * RPV)); }
__device__ __forceinline__ u32x4 scale8(u32x4 v, float w) {
    u32x4 o; o.x = pk2(bflo(v.x) * w, bfhi(v.x) * w); o.y = pk2(bflo(v.y) * w, bfhi(v.y) * w); o.z = pk2(bflo(v.z) * w, bfhi(v.z) * w); o.w = pk2(bflo(v.w) * w, bfhi(v.w) * w); return o;
}
__device__ __forceinline__ void r1_phase(LAS uchar* lds, int vcu, int G, const bf16_t* RK, const bf16_t* RV, float* KV, const float* dec_f, const float* dec_b) {
    const int tid = fresh_tid(), lane = tid & 63, wid = __builtin_amdgcn_readfirstlane(tid >> 6);
    LAS uchar* KF = lds; LAS uchar* KB = lds + 128 * RPV; LAS uchar* V = lds + 256 * RPV;
    u32x4 k8[2], v8[2];
#define R1_LOAD(u_) do { const int bh_ = (u_) >> 5, n_ = (u_) & 31; _Pragma("unroll") for (int i_ = 0; i_ < 2; ++i_) { const int p_ = tid + i_ * 512; \
        const size_t go_ = ((size_t)(bh_ >> 3) * SEQ + n_ * 128 + (p_ >> 3)) * 512 + (bh_ & 7) * 64 + (p_ & 7) * 8; k8[i_] = *(const u32x4*)(RK + go_); v8[i_] = *(const u32x4*)(RV + go_); } } while (0)
    int u = vcu;
    if (u < 2048) R1_LOAD(u);
    for (; u < 2048; u += G) {
        const int bh = u >> 5, n = u & 31, h = bh & 7;
        const float lgf2 = -log1pf(expf(-dec_f[h])) * LOG2E, lgb2 = -log1pf(expf(-dec_b[h])) * LOG2E;
#pragma unroll
        for (int i = 0; i < 2; ++i) {
            const int p = tid + i * 512, j = p >> 3, ch = p & 7;
            const float wf = __builtin_amdgcn_exp2f(lgf2 * (float)(127 - j)), wb = __builtin_amdgcn_exp2f(lgb2 * (float)j);
            *(LAS u32x4*)(KF + j * RPV + ch * 16) = scale8(k8[i], wf);
            *(LAS u32x4*)(KB + j * RPV + ch * 16) = scale8(k8[i], wb);
            *(LAS u32x4*)(V + j * RPV + ch * 16) = v8[i];
        }
        __syncthreads();
        if (u + G < 2048) R1_LOAD(u + G);
        const int dir = wid >> 2, eb = wid & 3, kq = lane >> 4, il = lane & 15, r = il >> 2, cc = il & 3;
        const LAS uchar* vA = V + (4 * kq + r) * RPV + (16 * eb + 4 * cc) * 2;
        const LAS uchar* kB = (dir ? KB : KF) + (4 * kq + r) * RPV + (4 * cc) * 2;
        f32x4 acc[4];
#pragma unroll
        for (int d = 0; d < 4; ++d) acc[d] = (f32x4){0.f, 0.f, 0.f, 0.f};
#pragma unroll
        for (int jc = 0; jc < 4; ++jc) {
            const bf16x8 A = trpair(vA + 32 * jc * RPV);
#pragma unroll
            for (int db = 0; db < 4; ++db) { const bf16x8 B = trpair(kB + 32 * jc * RPV + db * 32); acc[db] = __builtin_amdgcn_mfma_f32_16x16x32_bf16(A, B, acc[db], 0, 0, 0); }
        }
        float* dst = KV + ((size_t)(bh * 32 + n) * 2 + dir) * 4096 + (16 * eb + 4 * kq) * 64 + il;
#pragma unroll
        for (int db = 0; db < 4; ++db)
#pragma unroll
            for (int v = 0; v < 4; ++v) dst[v * 64 + 16 * db] = acc[db][v];
        __syncthreads();
    }
#undef R1_LOAD
}
__device__ __forceinline__ void r2_item(int item, const float* KV, bf16_t* ST, const float* dec_f, const float* dec_b) {
    const int e4 = item & 1023, dir = (item >> 10) & 1, bh = item >> 11, h = bh & 7;
    const float x = dir ? dec_b[h] : dec_f[h];
    const float g = expf(-128.0f * log1pf(expf(-x)));
    f32x4 S = (f32x4){0.f, 0.f, 0.f, 0.f};
    for (int s = 0; s < 32; ++s) {
        const int n = dir ? 31 - s : s;
        const size_t off = ((size_t)(bh * 32 + n) * 2 + dir) * 4096 + e4 * 4;
        u32x2 w; w.x = pk2(S[0], S[1]); w.y = pk2(S[2], S[3]);
        *(u32x2*)(ST + off) = w;
        const f32x4 kv = __builtin_nontemporal_load((const f32x4*)(KV + off));
        S = S * g + kv;
    }
}
__device__ __forceinline__ void r3_phase(LAS uchar* lds, int vcu, int G, const bf16_t* RQ, const bf16_t* RK, const bf16_t* RV, const bf16_t* RG, const bf16_t* ST, bf16_t* MIX,
                                         const float* gng_l, const float* dec_f, const float* dec_b) {
    const int tid = fresh_tid(), lane = tid & 63, wid = __builtin_amdgcn_readfirstlane(tid >> 6);
    LAS uchar* K = lds; LAS uchar* V = lds + 128 * RPR; LAS uchar* SF = V + 128 * RPV; LAS uchar* SB = SF + 64 * RPR;
    const int il = lane & 15, kq = lane >> 4, r = il >> 2, cc = il & 3;
    const int ic = 16 * wid + il;
    u32x4 k8[2], v8[2], sf8, sb8; bf16x8 qf[2]; u32x2 gw[4];
#define R3_LOAD(u_) do { const int bh_ = (u_) >> 5, n_ = (u_) & 31, b_ = bh_ >> 3, h_ = bh_ & 7; _Pragma("unroll") for (int i_ = 0; i_ < 2; ++i_) { const int p_ = tid + i_ * 512; \
        const size_t go_ = ((size_t)b_ * SEQ + n_ * 128 + (p_ >> 3)) * 512 + h_ * 64 + (p_ & 7) * 8; k8[i_] = __builtin_nontemporal_load((const u32x4*)(RK + go_)); v8[i_] = __builtin_nontemporal_load((const u32x4*)(RV + go_)); } \
        { const bf16_t* sp_ = ST + ((size_t)(bh_ * 32 + n_) * 2) * 4096 + (tid >> 3) * 64 + (tid & 7) * 8; sf8 = __builtin_nontemporal_load((const u32x4*)(sp_)); sb8 = __builtin_nontemporal_load((const u32x4*)(sp_ + 4096)); } \
        { const size_t tk_ = ((size_t)b_ * SEQ + n_ * 128 + ic) * 512 + h_ * 64; qf[0] = __builtin_nontemporal_load((const bf16x8*)(RQ + tk_ + 8 * kq)); qf[1] = __builtin_nontemporal_load((const bf16x8*)(RQ + tk_ + 32 + 8 * kq)); \
          _Pragma("unroll") for (int eb_ = 0; eb_ < 4; ++eb_) gw[eb_] = __builtin_nontemporal_load((const u32x2*)(RG + tk_ + 16 * eb_ + 4 * kq)); } } while (0)
    int u = vcu;
    if (u < 2048) R3_LOAD(u);
    for (; u < 2048; u += G) {
        const int bh = u >> 5, n = u & 31, b = bh >> 3, h = bh & 7;
        const float lgf2 = -log1pf(expf(-dec_f[h])) * LOG2E, lgb2 = -log1pf(expf(-dec_b[h])) * LOG2E;
        const float* gng = gng_l + h * 64;
#pragma unroll
        for (int i = 0; i < 2; ++i) { const int p = tid + i * 512, j = p >> 3, ch = p & 7; *(LAS u32x4*)(K + j * RPR + ch * 16) = k8[i]; *(LAS u32x4*)(V + j * RPV + ch * 16) = v8[i]; }
        { const int e = tid >> 3, ch = tid & 7; *(LAS u32x4*)(SF + e * RPR + ch * 16) = sf8; *(LAS u32x4*)(SB + e * RPR + ch * 16) = sb8; }
        const bf16x8 q0 = qf[0], q1 = qf[1]; const u32x2 g0_ = gw[0], g1_ = gw[1], g2_ = gw[2], g3_ = gw[3];
        __syncthreads();
        if (u + G < 2048) R3_LOAD(u + G);
        const size_t tok = (size_t)b * SEQ + n * 128 + ic;
        f32x4 s[8];
#pragma unroll
        for (int jb = 0; jb < 8; ++jb) {
            s[jb] = (f32x4){0.f, 0.f, 0.f, 0.f};
            { const bf16x8 A0 = *(const LAS bf16x8*)(K + (16 * jb + il) * RPR + (8 * kq) * 2), A1 = *(const LAS bf16x8*)(K + (16 * jb + il) * RPR + (32 + 8 * kq) * 2);
              s[jb] = __builtin_amdgcn_mfma_f32_16x16x32_bf16(A0, q0, s[jb], 0, 0, 0); s[jb] = __builtin_amdgcn_mfma_f32_16x16x32_bf16(A1, q1, s[jb], 0, 0, 0); }
#pragma unroll
            for (int v = 0; v < 4; ++v) { const float d = (float)(ic - (16 * jb + 4 * kq + v)); const float w = __builtin_amdgcn_exp2f((d >= 0.f ? lgf2 : -lgb2) * d); s[jb][v] *= w; }
        }
        bf16x8 pf[4];
#pragma unroll
        for (int jc = 0; jc < 4; ++jc) { u32x4 w; w.x = pk2(s[2 * jc][0], s[2 * jc][1]); w.y = pk2(s[2 * jc][2], s[2 * jc][3]); w.z = pk2(s[2 * jc + 1][0], s[2 * jc + 1][1]); w.w = pk2(s[2 * jc + 1][2], s[2 * jc + 1][3]); pf[jc] = __builtin_bit_cast(bf16x8, w); }
        const float cf = __builtin_amdgcn_exp2f(lgf2 * (float)(ic + 1)), cb = __builtin_amdgcn_exp2f(lgb2 * (float)(128 - ic));
        f32x4 y[4];
        const LAS uchar* vA = V + (4 * kq + r) * RPV + (4 * cc) * 2;
        float sum = 0.f;
#pragma unroll
        for (int eb = 0; eb < 4; ++eb) {
            f32x4 a = (f32x4){0.f, 0.f, 0.f, 0.f}, af = a, ab = a;
#pragma unroll
            for (int jc = 0; jc < 4; ++jc) a = __builtin_amdgcn_mfma_f32_16x16x32_bf16(trpair(vA + 32 * jc * RPV + eb * 32), pf[jc], a, 0, 0, 0);
            { const bf16x8 Af0 = *(const LAS bf16x8*)(SF + (16 * eb + il) * RPR + (8 * kq) * 2), Af1 = *(const LAS bf16x8*)(SF + (16 * eb + il) * RPR + (32 + 8 * kq) * 2);
              const bf16x8 Ab0 = *(const LAS bf16x8*)(SB + (16 * eb + il) * RPR + (8 * kq) * 2), Ab1 = *(const LAS bf16x8*)(SB + (16 * eb + il) * RPR + (32 + 8 * kq) * 2);
              af = __builtin_amdgcn_mfma_f32_16x16x32_bf16(Af0, q0, af, 0, 0, 0); af = __builtin_amdgcn_mfma_f32_16x16x32_bf16(Af1, q1, af, 0, 0, 0);
              ab = __builtin_amdgcn_mfma_f32_16x16x32_bf16(Ab0, q0, ab, 0, 0, 0); ab = __builtin_amdgcn_mfma_f32_16x16x32_bf16(Ab1, q1, ab, 0, 0, 0); }
            y[eb] = a + af * cf + ab * cb;
            sum += (y[eb][0] + y[eb][1]) + (y[eb][2] + y[eb][3]);
        }
        sum += __shfl_xor(sum, 16); sum += __shfl_xor(sum, 32);
        const float mean = sum * (1.0f / 64.0f);
        float q = 0.f;
#pragma unroll
        for (int eb = 0; eb < 4; ++eb) { y[eb] = y[eb] - mean; q += (y[eb][0] * y[eb][0] + y[eb][1] * y[eb][1]) + (y[eb][2] * y[eb][2] + y[eb][3] * y[eb][3]); }
        q += __shfl_xor(q, 16); q += __shfl_xor(q, 32);
        const float rstd = 1.0f / sqrtf(q * (1.0f / 64.0f) + EPS);
#pragma unroll
        for (int eb = 0; eb < 4; ++eb) {
            const int e0 = 16 * eb + 4 * kq;
            const u32x2 gwv = eb == 0 ? g0_ : eb == 1 ? g1_ : eb == 2 ? g2_ : g3_;
            const f32x4 gn = *(const f32x4*)(gng + e0);
            const float g0 = bflo(gwv.x), g1 = bfhi(gwv.x), g2 = bflo(gwv.y), g3 = bfhi(gwv.y);
            const float o0 = y[eb][0] * rstd * gn[0] * g0 / (1.0f + __expf(-g0)), o1 = y[eb][1] * rstd * gn[1] * g1 / (1.0f + __expf(-g1));
            const float o2 = y[eb][2] * rstd * gn[2] * g2 / (1.0f + __expf(-g2)), o3 = y[eb][3] * rstd * gn[3] * g3 / (1.0f + __expf(-g3));
            u32x2 w; w.x = pk2(o0, o1); w.y = pk2(o2, o3);
            *(u32x2*)(MIX + tok * 1024 + 512 + h * 64 + e0) = w;
        }
        __syncthreads();
    }
#undef R3_LOAD
}

#define XB_TMO      128
#define XB_XCNT(j)  (256  + 64 * (j))
#define XB_XSUB(j)  (1280 + 64 * (j))
#define XB_XGEN(j)  (2304 + 64 * (j))
#define XB_TOP      3328
#define XB_TOPGEN   3392
#define XCD_BAR_WORDS 3456
#define XB_SPIN_CAP (1u << 18)

__device__ __forceinline__ unsigned xb_ld(unsigned* p)              { return __hip_atomic_load(p, __ATOMIC_RELAXED, __HIP_MEMORY_SCOPE_AGENT); }
__device__ __forceinline__ unsigned xb_add(unsigned* p, unsigned v) { return __hip_atomic_fetch_add(p, v, __ATOMIC_RELAXED, __HIP_MEMORY_SCOPE_AGENT); }
__device__ __forceinline__ unsigned xb_xcc_id() { return (unsigned)__builtin_amdgcn_s_getreg((3 << 11) | 20) & 0xFu; }
#define XB_SPIN(cond, bar) do { unsigned _sp = 0; while (cond) { __builtin_amdgcn_s_sleep(1); \
    if ((++_sp & 255u) == 0u) { if (xb_ld(&(bar)[XB_TMO])) break; if (_sp > XB_SPIN_CAP) { atomicAdd(&(bar)[XB_TMO], 1u); break; } } } } while (0)

struct XcdBarrier {
    unsigned* bar; unsigned x;
    volatile LAS unsigned* st;
};

__device__ __forceinline__ XcdBarrier xcd_barrier_post(unsigned* bar, volatile LAS unsigned* st) {
    XcdBarrier b; b.bar = bar; b.x = xb_xcc_id(); b.st = st;
    if (threadIdx.x == 0) (void)xb_add(&bar[XB_XCNT(b.x)], 1u);
    return b;
}
__device__ __forceinline__ void xcd_barrier_complete(unsigned* bar, unsigned x, unsigned& nloc, unsigned& nx) {
    const unsigned G = gridDim.x * gridDim.y * gridDim.z;
    unsigned sum, cnt, mine, sp = 0u;
    for (;;) {
        sum = 0u; cnt = 0u; mine = 0u;
#pragma unroll
        for (unsigned j = 0; j < 16; ++j) { const unsigned c = xb_ld(&bar[XB_XCNT(j)]); sum += c; cnt += (c > 0u) ? 1u : 0u; mine = (j == x) ? c : mine; }
        if (sum == G) break;
        __builtin_amdgcn_s_sleep(1);
        if ((++sp & 255u) == 0u) { if (xb_ld(&bar[XB_TMO])) break; if (sp > XB_SPIN_CAP) { atomicAdd(&bar[XB_TMO], 1u); break; } }
    }
    nloc = mine > 0u ? mine : 1u; nx = cnt > 0u ? cnt : 1u;
}

__device__ __forceinline__ void xcd_barrier(const XcdBarrier& b) {
    asm volatile("s_waitcnt vmcnt(0)" ::: "memory");
    __syncthreads();
    if (threadIdx.x == 0) {
        unsigned* bar = b.bar;
        __builtin_amdgcn_s_waitcnt(0);
        unsigned nloc = b.st[0], nx = b.st[1];
        if (nloc == 0u) { xcd_barrier_complete(bar, b.x, nloc, nx); b.st[0] = nloc; b.st[1] = nx; }
        const unsigned old = xb_add(&bar[XB_XSUB(b.x)], 1u);
        const unsigned gen = old / nloc;
        if (old + 1u == (gen + 1u) * nloc) {
            __builtin_amdgcn_fence(__ATOMIC_RELEASE, "agent");
            asm volatile("s_waitcnt vmcnt(0)" ::: "memory");
            const unsigned og = xb_add(&bar[XB_TOP], 1u);
            const unsigned tg = og / nx;
            if (og + 1u == (tg + 1u) * nx) xb_add(&bar[XB_TOPGEN], 1u);
            else XB_SPIN(xb_ld(&bar[XB_TOPGEN]) == tg, bar);
            __builtin_amdgcn_fence(__ATOMIC_ACQUIRE, "agent");
            xb_add(&bar[XB_XGEN(b.x)], 1u);
            asm volatile("s_waitcnt vmcnt(0)" ::: "memory");
        } else {
            XB_SPIN(xb_ld(&bar[XB_XGEN(b.x)]) == gen, bar);
            __builtin_amdgcn_fence(__ATOMIC_ACQUIRE, "agent");
            asm volatile("s_waitcnt vmcnt(0)" ::: "memory");
        }
    }
    __syncthreads();
}

#ifndef PHMASK
#define PHMASK 0x3ff
#endif
#define PHM(i) (((PHMASK) >> (i)) & 1)
struct Args { const float* in[17]; float* out; uchar* ws; int ph_lo, ph_hi; };
constexpr int PH_PER_LAYER = 7, N_PHASES = 1 + DEPTH * PH_PER_LAYER;

__global__ void __launch_bounds__(NWAVES * 64, 2) mk_fwd(Args args) {
    extern __shared__ __attribute__((aligned(16))) uchar lds_raw[];
    LAS uchar* lds = (LAS uchar*)lds_raw;
    cg::grid_group grid = cg::this_grid();
    for (int u = threadIdx.x; u < 64; u += NWAVES * 64) ((LAS unsigned*)(lds + MISC_OFF))[u] = 0u;
    __syncthreads();
    XcdBarrier bar = xcd_barrier_post((unsigned*)(args.ws + WS_CTL), (volatile LAS unsigned*)(lds + MISC_OFF) + 8);
    for (int p = args.ph_lo; p < args.ph_hi; ++p) {
        const int tid = fresh_tid(), lane = tid & 63, wave = __builtin_amdgcn_readfirstlane(tid >> 6);
        int G = gridDim.x, bx = blockIdx.x; asm volatile("" : "+s"(G), "+s"(bx));
        const int vcu = (G % 8 == 0) ? (bx % 8) * (G / 8) + bx / 8 : bx;
        const int gw = vcu * NWAVES + wave, ngw = G * NWAVES;
        __attribute__((address_space(1))) uchar* wsg = (__attribute__((address_space(1))) uchar*)args.ws; asm volatile("" : "+s"(wsg)); uchar* ws = (uchar*)wsg;
        const float* x_in = args.in[0];
        float* out = args.out;
        bf16_t* XN = (bf16_t*)(ws + WS_XN); bf16_t* MIX = (bf16_t*)(ws + WS_MIX); bf16_t* PROJ = (bf16_t*)(ws + WS_PROJ); bf16_t* HB = (bf16_t*)(ws + WS_PROJ);
        float* KV = (float*)(ws + WS_MIX); bf16_t* ST = (bf16_t*)(ws + WS_ST); float* ROWSS = (float*)(ws + WS_ROWSS);
        const bf16_t* DQ = PROJ; const bf16_t* DK = PROJ + SEC / 2; const bf16_t* DV = PROJ + 2 * (SEC / 2);
        const bf16_t* RQ = PROJ + 3 * (SEC / 2); const bf16_t* RK = PROJ + 4 * (SEC / 2); const bf16_t* RV = PROJ + 5 * (SEC / 2); const bf16_t* RG = PROJ + 6 * (SEC / 2);
        if (PHM(0) && p == 0) {
            LAS float* scr = (LAS float*)(lds + wave * 16384);
            constexpr int I_IN = (DM / 64) * (NIN / 32), I_OUT = (DM / 64) * (DM / 32), I_1 = (DM / 64) * (FF / 32), I_2 = (FF / 64) * (DM / 32), I_L = I_IN + I_OUT + I_1 + I_2;
            for (int it = gw; it < DEPTH * I_L; it += ngw) {
                const int l = it / I_L; int r = it % I_L;
                bf16_t* wl = (bf16_t*)(ws + WS_W + (size_t)l * W_LAYER);
                if (r < I_IN) { transpose_item(args.in[2] + (size_t)l * DM * NIN, DM, NIN, (bf16_t*)((uchar*)wl + W_IN), args.in[1] + l * DM, true, scr, r, lane); continue; } r -= I_IN;
                if (r < I_OUT) { transpose_item(args.in[13] + (size_t)l * DM * DM, DM, DM, (bf16_t*)((uchar*)wl + W_OUT), nullptr, false, scr, r, lane); continue; } r -= I_OUT;
                if (r < I_1) { transpose_item(args.in[15] + (size_t)l * DM * FF, DM, FF, (bf16_t*)((uchar*)wl + W_1), args.in[14] + l * DM, false, scr, r, lane); continue; } r -= I_1;
                transpose_item(args.in[16] + (size_t)l * FF * DM, FF, DM, (bf16_t*)((uchar*)wl + W_2), nullptr, false, scr, r, lane);
            }
            norm_rows(x_in, XN, ROWSS, gw, ngw, lane);
        } else {
            const int l = (p - 1) / PH_PER_LAYER, k = (p - 1) % PH_PER_LAYER;
            const uchar* wl = ws + WS_W + (size_t)l * W_LAYER;
            if (PHM(1) && k == 0) {
                pg8::Gemm g{XN, (const bf16_t*)(wl + W_IN), M, NIN, DM}; pg8::StaticOrder S; S.init(M, NIN, G, bx);
                { pg8::Unit u0; S.next(0, u0); fill_rrt(lds, ROWSS + (size_t)(2 * l) * M * 16, u0.pm & ~15); }
                pg8::EpiProj E{PROJ, SEC / 2, args.in[3] + l * 64, args.in[4] + l * 64, (const LAS float*)(lds + RRT_OFF)};
                pg8::gemm_phase<pg8::EpiProj, pg8::StaticOrder, true, true>(lds, g, S, E);
            } else if (PHM(2) && k == 1) {
                r1_phase(lds, vcu, G, RK, RV, KV, args.in[10] + l * 8, args.in[11] + l * 8);
            } else if (PHM(3) && k == 2) {
                for (int it = vcu * 512 + tid; it < 64 * 2 * 1024; it += G * 512) r2_item(it, KV, ST, args.in[10] + l * 8, args.in[11] + l * 8);
            } else if (PHM(4) && k == 3) {
                const float lam_init = 0.8f - 0.6f * expf(-0.3f * (float)l);
                const int per = G / 8 > 0 ? G / 8 : 1;
                if (vcu & 1) { r3_phase(lds, vcu, G, RQ, RK, RV, RG, ST, MIX, args.in[12] + l * 512, args.in[10] + l * 8, args.in[11] + l * 8); __syncthreads(); }
                if (PHM(8)) for (int u = vcu; u < 1024; u += G) {
                    int bh, qb;
                    if (G == 256) { const int xc = vcu >> 5, c = vcu & 31, i = u / G; bh = xc * 4 + i; qb = (i == 1) ? ((c + 16) & 31) : c; } else { bh = u >> 5; qb = u & 31; }
                    const int b = bh >> 2, h = bh & 3;
                    const float s1 = wave_sum(args.in[5][(l * 4 + h) * 64 + lane] * args.in[6][(l * 4 + h) * 64 + lane]);
                    const float s2 = wave_sum(args.in[7][(l * 4 + h) * 64 + lane] * args.in[8][(l * 4 + h) * 64 + lane]);
                    const float lam = expf(s1) - expf(s2) + lam_init;
                    const float slope = exp2f(-2.0f * (float)(h + 1));
                    float gq = fabsf(args.in[3][l * 64 + lane]), gk = fabsf(args.in[4][l * 64 + lane]);
#pragma unroll
                    for (int o_ = 1; o_ < 64; o_ <<= 1) { gq = fmaxf(gq, __shfl_xor(gq, o_)); gk = fmaxf(gk, __shfl_xor(gk, o_)); }
                    const float wf_ = (2.0f * 8.0f * gq * gk + 110.0f) / slope;
                    const int Wi = wf_ < 1.0e6f ? (int)wf_ + 1 : 1000000;
                    int tlo = (qb * 128 - Wi) >> 6; if (tlo < 0) tlo = 0;
                    int thi = (qb * 128 + 127 + Wi) >> 6; if (thi > SEQ / 64 - 1) thi = SEQ / 64 - 1;
                    tlo = __builtin_amdgcn_readfirstlane(tlo); thi = __builtin_amdgcn_readfirstlane(thi);
                    attn_unit(lds, b, h, qb, DQ, DK, DV, MIX, lam, slope * LOG2E, 8.0f * gq * gk * LOG2E * 1.01f + 0.5f, args.in[9] + l * 512 + h * 128, 1.0f - lam_init, tlo, thi - tlo + 1);
                }
                (void)per;
                __syncthreads();
                if (!(vcu & 1)) r3_phase(lds, vcu, G, RQ, RK, RV, RG, ST, MIX, args.in[12] + l * 512, args.in[10] + l * 8, args.in[11] + l * 8);
            } else if (PHM(5) && (k == 4 || k == 6)) {
                pg8::Gemm g = (k == 4) ? pg8::Gemm{MIX, (const bf16_t*)(wl + W_OUT), M, DM, DM} : pg8::Gemm{HB, (const bf16_t*)(wl + W_2), M, DM, FF};
                pg8::StaticOrder S; S.init(M, DM, G, bx, k == 6 ? 1 : 0);
                const bool has_next = (k == 4) || (l + 1 < DEPTH);
                pg8::EpiRes E{XN, has_next ? nullptr : out, DM, ROWSS + (size_t)(k == 4 ? 2 * l + 1 : 2 * l + 2) * M * 16};
                pg8::gemm_phase<pg8::EpiRes, pg8::StaticOrder, true, true>(lds, g, S, E);
            } else if (PHM(7) && k == 5) {
                pg8::Gemm g{XN, (const bf16_t*)(wl + W_1), M, FF, DM}; pg8::StaticOrder S; S.init(M, FF, G, bx);
                { pg8::Unit u0; S.next(0, u0); fill_rrt(lds, ROWSS + (size_t)(2 * l + 1) * M * 16, u0.pm & ~15); }
                pg8::EpiRelu2 E{HB, FF, (const LAS float*)(lds + RRT_OFF)};
                pg8::gemm_phase<pg8::EpiRelu2, pg8::StaticOrder, true, true>(lds, g, S, E);
            }
        }
        if (p + 1 < args.ph_hi) { if (p == args.ph_lo) grid.sync(); else xcd_barrier(bar); }
    }
}

extern "C" void kernel_launch(void* const* d_in, const int* in_sizes, int n_in, void* d_out, int out_size, void* d_ws, size_t ws_size, hipStream_t stream) {
    static int grid = 0;
    if (grid == 0) {
        if (n_in != 17 || out_size != M * DM || ws_size < WS_END) { fprintf(stderr, "kernel_launch: unexpected shapes (n_in %d out %d ws %zu)\n", n_in, out_size, ws_size); grid = -1; return; }
        int dev = 0, cus = 0, per_cu = 0;
        hipGetDevice(&dev); hipDeviceGetAttribute(&cus, hipDeviceAttributeMultiprocessorCount, dev);
        if (hipFuncSetAttribute((const void*)mk_fwd, hipFuncAttributeMaxDynamicSharedMemorySize, LDS_BYTES) != hipSuccess) { fprintf(stderr, "kernel_launch: hipFuncSetAttribute failed\n"); grid = -1; return; }
        hipOccupancyMaxActiveBlocksPerMultiprocessor(&per_cu, (const void*)mk_fwd, NWAVES * 64, LDS_BYTES);
        (void)hipGetLastError();
        if (per_cu < 1) per_cu = 1;
        grid = cus * per_cu;
        fprintf(stderr, "kernel_launch: cus %d per_cu %d grid %d\n", cus, per_cu, grid);
    }
    if (grid < 0) return;
    if (hipMemsetAsync((char*)d_ws + WS_CTL, 0, CTL_BYTES, stream) != hipSuccess) { fprintf(stderr, "kernel_launch: memset failed\n"); return; }
    Args a{};
    for (int i = 0; i < 17; ++i) a.in[i] = (const float*)d_in[i];
    a.out = (float*)d_out; a.ws = (uchar*)d_ws;
#ifndef MK_MULTI
    a.ph_lo = 0; a.ph_hi = N_PHASES;
    void* kargs[] = {&a};
    hipError_t e = hipLaunchCooperativeKernel((const void*)mk_fwd, dim3(grid), dim3(NWAVES * 64), kargs, LDS_BYTES, stream);
    if (e != hipSuccess) fprintf(stderr, "cooperative launch failed: %s (grid %d)\n", hipGetErrorString(e), grid);
#else
    for (int p = 0; p < N_PHASES; ++p) { a.ph_lo = p; a.ph_hi = p + 1; hipLaunchKernelGGL(mk_fwd, dim3(grid), dim3(NWAVES * 64), LDS_BYTES, stream, a); }
#endif
}
```
